# Optimizing an MI355X kernel written in HIP

```python
import math
import jax, jax.numpy as jnp
from jax import lax
import numpy as np

D_MODEL = 1024
BATCH = 16
SEQ = 2048
DEPTH = 2

CHUNK = 64
MEM_LEN = 256
EPS = 1e-6

FOX_HEAD_DIM = 64
FOX_HEADS = D_MODEL // 128
FOX_WIDTH = FOX_HEADS * FOX_HEAD_DIM
FOX_Q_BLOCK = 128

MLSTM_HEADS = 4
MLSTM_HEAD_DIM = D_MODEL // 8
MLSTM_WIDTH = MLSTM_HEADS * MLSTM_HEAD_DIM
MLSTM_CHUNK = CHUNK
CONV_WIDTH = 4

GMLP_GROUPS = 4
GMLP_GROUP_DIM = D_MODEL // 8
GMLP_WIDTH = GMLP_GROUPS * GMLP_GROUP_DIM
GMLP_SPAN = 128

N_BRANCH = 3
BRANCH_WIDTH = D_MODEL // 2

XATTN_HEADS = 4
XATTN_HEAD_DIM = D_MODEL // XATTN_HEADS

D_FF = 4 * D_MODEL

NORM_MIX_PRE, NORM_MIX_POST, NORM_X_PRE, NORM_X_POST, NORM_MEM, NORM_FF_PRE, NORM_FF_POST = 0, 1, 2, 3, 4, 5, 6
N_NORMS = 7

IN_SPLITS = (
    ("fox_q", FOX_WIDTH), ("fox_k", FOX_WIDTH), ("fox_v", FOX_WIDTH), ("fox_f", FOX_HEADS),
    ("ml_q", MLSTM_WIDTH), ("ml_k", MLSTM_WIDTH), ("ml_v", MLSTM_WIDTH),
    ("ml_i", MLSTM_HEADS), ("ml_f", MLSTM_HEADS), ("ml_o", MLSTM_WIDTH),
    ("g_u", GMLP_WIDTH), ("g_v", GMLP_WIDTH),
    ("gate", N_BRANCH * D_MODEL),
)
D_IN = sum(size for _, size in IN_SPLITS)

kernel_name = "hybrid_fox_mlstm_gmlp_streaming_encoder"


def rms_norm(x, g):
    x32 = x.astype(jnp.float32)
    y = x32 * lax.rsqrt(jnp.mean(x32 * x32, axis=-1, keepdims=True) + EPS)
    return y.astype(x.dtype) * g


def layer_norm(x, g):
    x32 = x.astype(jnp.float32)
    mu = jnp.mean(x32, axis=-1, keepdims=True)
    xc = x32 - mu
    y = xc * lax.rsqrt(jnp.mean(xc * xc, axis=-1, keepdims=True) + EPS)
    return y.astype(x.dtype) * g


def split_columns(z):
    parts = []
    start = 0
    for _, size in IN_SPLITS:
        parts.append(z[..., start:start + size])
        start += size
    return parts


def causal_conv(x, w):
    K = w.shape[0]
    S = x.shape[1]
    xp = jnp.pad(x, ((0, 0), (K - 1, 0), (0, 0)))
    y = w[0] * xp[:, 0:S]
    for j in range(1, K):
        y = y + w[j] * xp[:, j:j + S]
    return y


def fox_attention(q, k, v, f_pre):
    B, S, H, dh = q.shape
    F = jnp.cumsum(jax.nn.log_sigmoid(f_pre.astype(jnp.float32)), axis=1)
    F = F.transpose(0, 2, 1)
    q = q.transpose(0, 2, 1, 3) * (dh ** -0.5)
    k = k.transpose(0, 2, 1, 3)
    v = v.transpose(0, 2, 1, 3)
    outs = []
    for blk in range(S // FOX_Q_BLOCK):
        q0 = blk * FOX_Q_BLOCK
        q1 = q0 + FOX_Q_BLOCK
        s = jnp.einsum('bhqd,bhkd->bhqk', q[:, :, q0:q1], k[:, :, :q1]).astype(jnp.float32)
        s = s + F[:, :, q0:q1, None] - F[:, :, None, :q1]
        causal = jnp.arange(q0, q1)[:, None] >= jnp.arange(q1)[None, :]
        s = jnp.where(causal, s, -jnp.inf)
        p = jax.nn.softmax(s, axis=-1).astype(v.dtype)
        outs.append(jnp.einsum('bhqk,bhkd->bqhd', p, v[:, :, :q1]))
    return jnp.concatenate(outs, axis=1).reshape(B, S, H * dh)


def mlstm(q, k, v, i_pre, f_pre):
    B, S, H, d = q.shape
    L = MLSTM_CHUNK
    NC = S // L
    out_dtype = q.dtype

    def to_chunks(a):
        a = a.astype(jnp.float32).reshape((B, NC, L, H) + a.shape[3:])
        return jnp.moveaxis(a, (1, 3), (0, 2))

    qc = to_chunks(q)
    kc = to_chunks(k) * (d ** -0.5)
    vc = to_chunks(v)
    ic = to_chunks(i_pre)
    lfc = to_chunks(jax.nn.log_sigmoid(f_pre.astype(jnp.float32)))
    tril = jnp.tril(jnp.ones((L, L), dtype=bool))

    def step(carry, xs):
        C, n, m_prev = carry
        qb, kb, vb, ib, lfb = xs
        b = jnp.cumsum(lfb, axis=-1)
        D = jnp.where(tril, b[..., :, None] - b[..., None, :] + ib[..., None, :], -jnp.inf)
        inter = b + m_prev[..., None]
        m = jnp.maximum(inter, jnp.max(D, axis=-1))
        w_inter = jnp.exp(inter - m)
        P = jnp.einsum('bhtd,bhsd->bhts', qb, kb) * jnp.exp(D - m[..., None])
        num = w_inter[..., None] * jnp.einsum('bhtd,bhde->bhte', qb, C) + jnp.einsum('bhts,bhse->bhte', P, vb)
        den = w_inter * jnp.einsum('bhtd,bhd->bht', qb, n) + jnp.sum(P, axis=-1)
        h = num / jnp.maximum(jnp.abs(den), jnp.exp(-m))[..., None]
        m_new = m[..., -1]
        decay = jnp.exp(b[..., -1] + m_prev - m_new)
        w_s = jnp.exp(b[..., -1:] - b + ib - m_new[..., None])
        C_new = decay[..., None, None] * C + jnp.einsum('bhs,bhsd,bhse->bhde', w_s, kb, vb)
        n_new = decay[..., None] * n + jnp.einsum('bhs,bhsd->bhd', w_s, kb)
        return (C_new, n_new, m_new), h

    init = (jnp.zeros((B, H, d, d), jnp.float32),
            jnp.zeros((B, H, d), jnp.float32),
            jnp.zeros((B, H), jnp.float32))
    _, h = lax.scan(step, init, (qc, kc, vc, ic, lfc))
    h = jnp.moveaxis(h, (0, 2), (1, 3)).reshape(B, S, H, d)
    return h.astype(out_dtype)


def gmlp_sgu(u, v, norm_g, ws, bs):
    B, S, _ = u.shape
    u = jax.nn.gelu(u)
    v = layer_norm(jax.nn.gelu(v), norm_g)
    NG = S // GMLP_SPAN
    vg = v.reshape(B, NG, GMLP_SPAN, GMLP_GROUPS, GMLP_GROUP_DIM)
    pos_chunk = jnp.arange(GMLP_SPAN) // CHUNK
    mask = pos_chunk[:, None] >= pos_chunk[None, :]
    ws = jnp.where(mask, ws, 0)
    mixed = jnp.einsum('gts,bnsgc->bntgc', ws, vg) + bs.T[:, :, None]
    return u * mixed.reshape(B, S, GMLP_WIDTH)


def hybrid_mixer(h, w_in, b_in, conv_w, mlstm_g, gmlp_g, gmlp_ws, gmlp_bs, w_branch, w_out):
    B, S, _ = h.shape
    z = h @ w_in + b_in
    (fq, fk, fv, ff, mq, mk, mv, mi, mf, mo, gu, gv, gate) = split_columns(z)

    shp_f = (B, S, FOX_HEADS, FOX_HEAD_DIM)
    y_fox = fox_attention(fq.reshape(shp_f), fk.reshape(shp_f), fv.reshape(shp_f), ff)

    qk = jax.nn.silu(causal_conv(jnp.concatenate([mq, mk], axis=-1), conv_w))
    mq, mk = qk[..., :MLSTM_WIDTH], qk[..., MLSTM_WIDTH:]
    shp_m = (B, S, MLSTM_HEADS, MLSTM_HEAD_DIM)
    hm = mlstm(mq.reshape(shp_m), mk.reshape(shp_m), mv.reshape(shp_m), mi, mf)
    hm = rms_norm(hm, mlstm_g.reshape(MLSTM_HEADS, MLSTM_HEAD_DIM)).reshape(B, S, MLSTM_WIDTH)
    y_ml = jax.nn.sigmoid(mo) * hm

    y_g = gmlp_sgu(gu, gv, gmlp_g, gmlp_ws, gmlp_bs)

    ys = jnp.stack([y_fox, y_ml, y_g], axis=2)
    branches = jnp.einsum('bsnc,ncd->bsnd', ys, w_branch)
    gates = jax.nn.sigmoid(gate.reshape(B, S, N_BRANCH, D_MODEL))
    merged = jnp.sum(gates * branches, axis=2)
    return merged @ w_out


def cross_attention(h, mem_n, w_q, w_kv, w_o):
    B, S, _ = h.shape
    M = mem_n.shape[1]
    q = (h @ w_q).reshape(B, S, XATTN_HEADS, XATTN_HEAD_DIM)
    kv = mem_n @ w_kv
    k = kv[..., :D_MODEL].reshape(B, M, XATTN_HEADS, XATTN_HEAD_DIM)
    v = kv[..., D_MODEL:].reshape(B, M, XATTN_HEADS, XATTN_HEAD_DIM)
    s = jnp.einsum('bqhd,bkhd->bhqk', q, k).astype(jnp.float32) * (XATTN_HEAD_DIM ** -0.5)
    p = jax.nn.softmax(s, axis=-1).astype(v.dtype)
    o = jnp.einsum('bhqk,bkhd->bqhd', p, v).reshape(B, S, D_MODEL)
    return o @ w_o


def setup_inputs(seed: int = 0) -> dict:
    key = jax.random.key(seed)
    ks = jax.random.split(key, 20)
    f32 = jnp.float32

    def normal(k, shape, scale):
        return jax.random.normal(k, shape, f32) * scale

    x = normal(ks[0], (BATCH, SEQ, D_MODEL), 1.0)
    mem = normal(ks[1], (BATCH, MEM_LEN, D_MODEL), 1.0)
    norms = 1.0 + normal(ks[2], (DEPTH, N_NORMS, D_MODEL), 0.05)
    w_in = normal(ks[3], (DEPTH, D_MODEL, D_IN), D_MODEL ** -0.5)
    seg_keys = jax.random.split(ks[4], len(IN_SPLITS))
    parts = []
    for (name, size), kk in zip(IN_SPLITS, seg_keys):
        if name == "fox_f":
            parts.append(jax.random.uniform(kk, (DEPTH, size), f32, 1.0, 4.0))
        elif name == "ml_f":
            parts.append(jax.random.uniform(kk, (DEPTH, size), f32, 3.0, 6.0))
        elif name == "ml_i":
            parts.append(normal(kk, (DEPTH, size), 0.1))
        else:
            parts.append(normal(kk, (DEPTH, size), 0.02))
    b_in = jnp.concatenate(parts, axis=-1)
    conv_w = normal(ks[5], (DEPTH, CONV_WIDTH, 2 * MLSTM_WIDTH), CONV_WIDTH ** -0.5)
    mlstm_norm = 1.0 + normal(ks[6], (DEPTH, MLSTM_WIDTH), 0.05)
    gmlp_norm = 1.0 + normal(ks[7], (DEPTH, GMLP_WIDTH), 0.05)
    gmlp_ws = normal(ks[8], (DEPTH, GMLP_GROUPS, GMLP_SPAN, GMLP_SPAN), GMLP_SPAN ** -0.5)
    gmlp_bs = 1.0 + normal(ks[9], (DEPTH, GMLP_GROUPS, GMLP_SPAN), 0.1)
    w_branch = normal(ks[10], (DEPTH, N_BRANCH, BRANCH_WIDTH, D_MODEL), BRANCH_WIDTH ** -0.5)
    w_out = normal(ks[11], (DEPTH, D_MODEL, D_MODEL), D_MODEL ** -0.5)
    w_xq = normal(ks[12], (DEPTH, D_MODEL, D_MODEL), D_MODEL ** -0.5)
    w_xkv = normal(ks[13], (DEPTH, D_MODEL, 2 * D_MODEL), D_MODEL ** -0.5)
    w_xo = normal(ks[14], (DEPTH, D_MODEL, D_MODEL), D_MODEL ** -0.5)
    w_ff1 = normal(ks[15], (DEPTH, D_MODEL, D_FF), D_MODEL ** -0.5)
    w_ff2 = normal(ks[16], (DEPTH, D_FF, D_MODEL), D_FF ** -0.5)
    return {"x": x, "mem": mem, "norms": norms, "w_in": w_in, "b_in": b_in,
            "conv_w": conv_w, "mlstm_norm": mlstm_norm, "gmlp_norm": gmlp_norm,
            "gmlp_ws": gmlp_ws, "gmlp_bs": gmlp_bs, "w_branch": w_branch, "w_out": w_out,
            "w_xq": w_xq, "w_xkv": w_xkv, "w_xo": w_xo, "w_ff1": w_ff1, "w_ff2": w_ff2}


def reference(x, mem, norms, w_in, b_in, conv_w, mlstm_norm, gmlp_norm, gmlp_ws, gmlp_bs,
              w_branch, w_out, w_xq, w_xkv, w_xo, w_ff1, w_ff2):
    for l in range(DEPTH):
        g = norms[l]
        h = rms_norm(x, g[NORM_MIX_PRE])
        y = hybrid_mixer(h, w_in[l], b_in[l], conv_w[l], mlstm_norm[l], gmlp_norm[l],
                         gmlp_ws[l], gmlp_bs[l], w_branch[l], w_out[l])
        x = x + rms_norm(y, g[NORM_MIX_POST])
        h = rms_norm(x, g[NORM_X_PRE])
        mem_n = rms_norm(mem, g[NORM_MEM])
        y = cross_attention(h, mem_n, w_xq[l], w_xkv[l], w_xo[l])
        x = x + rms_norm(y, g[NORM_X_POST])
        h = rms_norm(x, g[NORM_FF_PRE])
        y = jnp.square(jax.nn.relu(h @ w_ff1[l])) @ w_ff2[l]
        x = x + rms_norm(y, g[NORM_FF_POST])
    return x
```

```cpp
#include <hip/hip_runtime.h>
#include <hip/hip_cooperative_groups.h>
#include <cstdio>
#include <cstdint>
namespace cg = cooperative_groups;

#ifndef MK_MULTI
#define MK_MULTI 1
#endif

#define LAS __attribute__((address_space(3)))
typedef unsigned short bf16_t;
typedef short bf16x8 __attribute__((ext_vector_type(8)));
typedef float f32x4 __attribute__((ext_vector_type(4)));
typedef unsigned u32x4 __attribute__((ext_vector_type(4)));
typedef unsigned u32x2 __attribute__((ext_vector_type(2)));
typedef float f32x2_t __attribute__((ext_vector_type(2)));
typedef __bf16 bf16x2_t __attribute__((ext_vector_type(2)));

namespace pg8 {
#define PG8_LAS __attribute__((address_space(3)))
constexpr int BM = 256, BK = 64, HALF = 128, HTB = HALF * BK * 2, STAGE_BYTES = 8 * HTB, NXCD = 8, WGM = 8;

__host__ __device__ __forceinline__ int lds_byte(int r, int c) { const int st = (r >> 4) * 2 + (c >> 5), rr = r & 15, cc = c & 31, ob = rr * 64 + cc * 2; return st * 1024 + (ob ^ (((ob >> 9) & 1) << 5)); }
__host__ __device__ __forceinline__ void stage_rc(int b, int& R, int& C) { const int st = b / 1024, sb = b % 1024, swz = sb ^ (((sb >> 9) & 1) << 5); R = (st >> 1) * 16 + swz / 64; C = (st & 1) * 32 + (swz % 64) / 2; }
__host__ __device__ __forceinline__ int perm32(int rho) { const int n = rho >> 4, i = rho & 15; return 8 * (i >> 2) + 4 * n + (i & 3); }

struct Unit { int pm, pn, sub; long aoff, boff; };
struct Gemm { const bf16_t* A; const bf16_t* Bt; int lda, K; };

template <class Epi, class Sched, bool ALIGN_EPI>
__device__ __forceinline__ void gemm_phase(PG8_LAS unsigned char* lds, const Gemm g, const Sched& S, const Epi& E, int tid) {
    asm volatile("" : "+v"(tid));
    const int wid = __builtin_amdgcn_readfirstlane(tid >> 6), lane = tid & 63, wr = wid >> 2, wc = wid & 3, fr = lane & 15, fq = lane >> 4;
    const int K = g.K, nt = K / BK, lda = g.lda;
    unsigned voffA[2], voffB[2];
#pragma unroll
    for (int i = 0; i < 2; ++i) { int R, C; stage_rc(tid * 16 + i * 8192, R, C); const int Rb = Epi::PERM ? ((R & ~31) + perm32(R & 31)) : R;
        voffA[i] = (unsigned)(R * lda + C) * 2u; voffB[i] = (unsigned)(Rb * K + C) * 2u; }
    const size_t kstep = (size_t)(BK * 2);
    const size_t hstepA = (size_t)HALF * lda * 2, hstepB = (size_t)HALF * K * 2;
    const unsigned ldsw = (unsigned)wid * 1024u;
    const int aoff = lds_byte(wr * 64 + fr, fq * 8), boff = lds_byte(wc * 32 + fr, fq * 8);
#define PG8_SA(b, h) (((b) * 2 + (h)) * HTB)
#define PG8_SB(b, h) ((4 + (b) * 2 + (h)) * HTB)
#define PG8_STAGE(bufoff, gbase, voff) do { _Pragma("unroll") for (int _i = 0; _i < 2; ++_i) \
        __builtin_amdgcn_global_load_lds((const unsigned*)((const char*)(gbase) + (voff)[_i]), (PG8_LAS unsigned*)(lds + (bufoff) + ldsw + _i * 8192), 16, 0, 0); } while (0)
#define PG8_LDA(dst, b, h) do { _Pragma("unroll") for (int m = 0; m < 4; ++m) _Pragma("unroll") for (int k = 0; k < 2; ++k) dst[m][k] = *(const PG8_LAS bf16x8*)(lds + PG8_SA(b, h) + aoff + m * 2048 + k * 1024); } while (0)
#define PG8_LDB(dst, b, h) do { _Pragma("unroll") for (int n = 0; n < 2; ++n) _Pragma("unroll") for (int k = 0; k < 2; ++k) dst[n][k] = *(const PG8_LAS bf16x8*)(lds + PG8_SB(b, h) + boff + n * 2048 + k * 1024); } while (0)
#define PG8_MMA(ai, bj, At, Bt) do { __builtin_amdgcn_s_setprio(1); _Pragma("unroll") for (int m = 0; m < 4; ++m) _Pragma("unroll") for (int n = 0; n < 2; ++n) _Pragma("unroll") for (int k = 0; k < 2; ++k) \
        acc[ai][bj][m][n] = __builtin_amdgcn_mfma_f32_16x16x32_bf16(Bt[n][k], At[m][k], acc[ai][bj][m][n], 0, 0, 0); __builtin_amdgcn_s_setprio(0); } while (0)
#define PG8_WAIT_V(n) asm volatile("s_waitcnt vmcnt(" #n ")" ::: "memory")
#define PG8_WAIT_L(n) asm volatile("s_waitcnt lgkmcnt(" #n ")" ::: "memory")
#define PG8_BAR __builtin_amdgcn_s_barrier()
#define PG8_SCHED __builtin_amdgcn_sched_barrier(0)
    Unit cur, nxt; int ui = 0;
    if (!S.next(0, cur)) return;
    f32x4 acc[2][2][4][2];
#pragma unroll
    for (int a = 0; a < 2; ++a)
#pragma unroll
        for (int b = 0; b < 2; ++b)
#pragma unroll
            for (int m = 0; m < 4; ++m)
#pragma unroll
                for (int n = 0; n < 2; ++n) acc[a][b][m][n] = (f32x4){0.f, 0.f, 0.f, 0.f};
    bf16x8 At[4][2], B0[2][2], B1[2][2];
    const char* cA = (const char*)g.A + cur.aoff * 2; const char* cB = (const char*)g.Bt + cur.boff * 2;
    PG8_STAGE(PG8_SB(0, 0), cB, voffB); PG8_STAGE(PG8_SB(0, 1), cB + hstepB, voffB); PG8_STAGE(PG8_SA(0, 0), cA, voffA); PG8_STAGE(PG8_SA(0, 1), cA + hstepA, voffA);
    if (wr == 1) PG8_BAR;
    PG8_WAIT_V(2); PG8_BAR;
    PG8_STAGE(PG8_SB(1, 0), cB + kstep, voffB); PG8_STAGE(PG8_SA(1, 0), cA + kstep, voffA); PG8_STAGE(PG8_SB(1, 1), cB + hstepB + kstep, voffB);
    PG8_WAIT_V(6); PG8_BAR;
    for (;;) {
        const bool has_next = S.next(ui + 1, nxt);
        const char* nA = has_next ? (const char*)g.A + nxt.aoff * 2 : cA; const char* nB = has_next ? (const char*)g.Bt + nxt.boff * 2 : cB;
        for (int t = 0; t < nt; t += 2) {
            const bool last = (t == nt - 2);
            const char* a1 = cA + (size_t)(t + 1) * kstep;
            const char* a2 = last ? nA : cA + (size_t)(t + 2) * kstep; const char* b2 = last ? nB : cB + (size_t)(t + 2) * kstep;
            const char* a3 = a2 + kstep; const char* b3 = b2 + kstep;
            PG8_LDB(B0, 0, 0); PG8_LDB(B1, 0, 1); PG8_SCHED; PG8_LDA(At, 0, 0); PG8_STAGE(PG8_SA(1, 1), a1 + hstepA, voffA);
            PG8_WAIT_V(8); PG8_WAIT_L(0); PG8_BAR; PG8_MMA(0, 0, At, B0); PG8_MMA(0, 1, At, B1); PG8_BAR; PG8_SCHED;
            PG8_LDA(At, 0, 1); PG8_STAGE(PG8_SB(0, 0), b2, voffB); PG8_STAGE(PG8_SB(0, 1), b2 + hstepB, voffB); PG8_STAGE(PG8_SA(0, 0), a2, voffA);
            PG8_WAIT_V(8); PG8_WAIT_L(0); PG8_BAR; PG8_MMA(1, 0, At, B0); PG8_MMA(1, 1, At, B1); PG8_BAR; PG8_SCHED;
            PG8_LDB(B0, 1, 0); PG8_LDB(B1, 1, 1); PG8_SCHED; PG8_LDA(At, 1, 0); PG8_STAGE(PG8_SA(0, 1), a2 + hstepA, voffA);
            PG8_WAIT_V(8); PG8_WAIT_L(0); PG8_BAR; PG8_MMA(0, 0, At, B0); PG8_MMA(0, 1, At, B1); PG8_BAR; PG8_SCHED;
            PG8_LDA(At, 1, 1); PG8_STAGE(PG8_SB(1, 0), b3, voffB); PG8_STAGE(PG8_SB(1, 1), b3 + hstepB, voffB); PG8_STAGE(PG8_SA(1, 0), a3, voffA);
            PG8_WAIT_V(8); PG8_WAIT_L(0); PG8_BAR; PG8_MMA(1, 0, At, B0); PG8_MMA(1, 1, At, B1); PG8_BAR; PG8_SCHED;
        }
        if constexpr (ALIGN_EPI) { if (wr == 0) PG8_BAR; }
        E(acc, cur, wr, wc, fr, fq);
        if (!has_next) break;
#pragma unroll
        for (int a = 0; a < 2; ++a)
#pragma unroll
            for (int b = 0; b < 2; ++b)
#pragma unroll
                for (int m = 0; m < 4; ++m)
#pragma unroll
                    for (int n = 0; n < 2; ++n) acc[a][b][m][n] = (f32x4){0.f, 0.f, 0.f, 0.f};
        cur = nxt; cA = nA; cB = nB; ++ui;
        if constexpr (ALIGN_EPI) { if (wr == 1) PG8_BAR; }
    }
    PG8_WAIT_V(0);
    if constexpr (!ALIGN_EPI) { if (wr == 0) PG8_BAR; }
    PG8_BAR;
#undef PG8_SA
#undef PG8_SB
#undef PG8_STAGE
#undef PG8_LDA
#undef PG8_LDB
#undef PG8_MMA
#undef PG8_WAIT_V
#undef PG8_WAIT_L
#undef PG8_BAR
#undef PG8_SCHED
}
}

constexpr int D = 1024, BATCH = 16, SEQ = 2048, MTOK = BATCH * SEQ, DEPTH = 2, MEMR = 16 * 256, DFF = 4096, DIN = 7696;
constexpr int LDZ = 5888, HCOL = 4864;
constexpr int ZC_FQ = 0, ZC_FK = 512, ZC_FV = 1024, ZC_MQ = 1536, ZC_MK = 2048, ZC_MV = 2560, ZC_MO = 3072, ZC_GU = 3584, ZC_GV = 4096, ZC_SM = 4608;
constexpr int ZC_SCR = 1024;
constexpr float EPS = 1e-6f;
constexpr int NPHASE = 25;
constexpr int LDS_BYTES = 147456;

constexpr size_t MiB = 1u << 20;
constexpr size_t WS_CTL = 0;
constexpr size_t WS_WIN = 1 * MiB;
constexpr size_t WS_WM = WS_WIN + (size_t)4864 * 1024 * 2;
constexpr size_t WS_WO = WS_WM + (size_t)6144 * 1024 * 2;
constexpr size_t WS_WXQ = WS_WO + 2 * MiB;
constexpr size_t WS_WXKV = WS_WXQ + 2 * MiB;
constexpr size_t WS_WXO = WS_WXKV + 4 * MiB;
constexpr size_t WS_W1 = WS_WXO + 2 * MiB;
constexpr size_t WS_W2 = WS_W1 + 8 * MiB;
constexpr size_t WS_BIASZ = WS_W2 + 8 * MiB;
constexpr size_t WS_KV = 50 * MiB;
constexpr size_t WS_MEMN = 66 * MiB;
constexpr size_t WS_ZH = 74 * MiB;
constexpr size_t WS_MRG = 442 * MiB;
constexpr size_t WS_END = 506 * MiB;
static_assert(WS_BIASZ + 4864 * 4 <= WS_KV, "ws map");

__device__ __forceinline__ float bf_lo(unsigned u) { return __uint_as_float(u << 16); }
__device__ __forceinline__ float bf_hi(unsigned u) { return __uint_as_float(u & 0xffff0000u); }
__device__ __forceinline__ float bf2f(bf16_t b) { return __uint_as_float(((unsigned)b) << 16); }
__device__ __forceinline__ unsigned pk2(float lo, float hi) { f32x2_t v = {lo, hi}; bf16x2_t b = __builtin_convertvector(v, bf16x2_t); return __builtin_bit_cast(unsigned, b); }
__device__ __forceinline__ bf16_t f2bf(float f) { return (bf16_t)(pk2(f, 0.f) & 0xffffu); }
__device__ __forceinline__ float wave_sum(float v) {
#pragma unroll
    for (int o = 1; o < 64; o <<= 1) v += __shfl_xor(v, o);
    return v;
}
__device__ __forceinline__ float sigmoidf_(float x) { return 1.f / (1.f + __expf(-x)); }
__device__ __forceinline__ float logsigmoidf_(float x) { return fminf(x, 0.f) - log1pf(__expf(-fabsf(x))); }
__device__ __forceinline__ float gelu_tanh(float x) { const float u = 0.7978845608028654f * (x + 0.044715f * x * x * x); const float t = 1.f - 2.f / (__expf(2.f * u) + 1.f); return 0.5f * x * (1.f + t); }
#define MFMA16(a, b, c) __builtin_amdgcn_mfma_f32_16x16x32_bf16((a), (b), (c), 0, 0, 0)
__device__ __forceinline__ bf16x8 frag(const LAS bf16_t* p, int ld, int row0, int k0, int lane) { return *(const LAS bf16x8*)(p + (row0 + (lane & 15)) * ld + k0 + (lane >> 4) * 8); }
#define LDS_FENCE() asm volatile("s_waitcnt lgkmcnt(0)" ::: "memory")

__device__ __forceinline__ void tile_map(int wgid, int nM, int nN, int& pm, int& pn) {
    const int nwg = nM * nN;
    { const int q = nwg / pg8::NXCD, r = nwg % pg8::NXCD, xcd = wgid % pg8::NXCD, off = wgid / pg8::NXCD; wgid = (xcd < r ? xcd * (q + 1) : r * (q + 1) + (xcd - r) * q) + off; }
    const int nig = pg8::WGM * nN, gid = wgid / nig, fm = gid * pg8::WGM, gsz = (nM - fm) < pg8::WGM ? (nM - fm) : pg8::WGM;
    pm = fm + ((wgid % nig) % gsz); pn = (wgid % nig) / gsz;
}
struct USched {
    int mode;
    int G, c, nM0, nN0, nM1, nN1;
    long lda, K, a0col, a1off, b1off;
    __device__ __forceinline__ bool next(int i, pg8::Unit& u) const {
        if (mode == 2) {
            const int ti = i / 6, s = i - ti * 6; const long L = (long)ti * G + c; if (L >= (long)nM0 * nN0) return false;
            int pm, pn; tile_map((int)L, nM0, nN0, pm, pn);
            const int n = s >> 1, br = s & 1;
            const long acol = br ? (n == 0 ? (long)ZC_FQ : (n == 1 ? (long)ZC_MO : (long)ZC_GU)) : (long)HCOL;
            u.pm = pm; u.pn = pn; u.sub = s; u.aoff = (long)pm * 256 * lda + acol; u.boff = ((long)(br ? 3072 : 0) + n * 1024 + pn * 256) * K; return true;
        }
        const long L = (long)i * G + c; const long n0 = (long)nM0 * nN0;
        if (L < n0) { int pm, pn; tile_map((int)L, nM0, nN0, pm, pn); u.pm = pm; u.pn = pn; u.sub = 0; u.aoff = (long)pm * 256 * lda + a0col; u.boff = (long)pn * 256 * K; return true; }
        if (mode == 1 && L < n0 + (long)nM1 * nN1) { int pm, pn; tile_map((int)(L - n0), nM1, nN1, pm, pn); u.pm = pm; u.pn = pn; u.sub = 1; u.aoff = a1off + (long)pm * 256 * lda; u.boff = b1off + (long)pn * 256 * K; return true; }
        return false;
    }
};

struct EpiStore {
    static constexpr bool PERM = true;
    bf16_t* O0; bf16_t* O1; int ldc0, ldc1, act; const float* bias;
    __device__ __forceinline__ void operator()(const f32x4 (&acc)[2][2][4][2], const pg8::Unit& u, int wr, int wc, int fr, int fq) const {
        bf16_t* base = u.sub ? O1 : O0; const int ldc = u.sub ? ldc1 : ldc0;
        const int row0 = u.pm * 256 + wr * 64 + fr, col0 = u.pn * 256 + wc * 32 + 8 * fq;
        f32x4 bv[2][2];
#pragma unroll
        for (int bj = 0; bj < 2; ++bj)
#pragma unroll
            for (int n = 0; n < 2; ++n) bv[bj][n] = bias ? *(const f32x4*)(bias + col0 + bj * 128 + 4 * n) : (f32x4){0.f, 0.f, 0.f, 0.f};
#pragma unroll
        for (int ai = 0; ai < 2; ++ai)
#pragma unroll
            for (int m = 0; m < 4; ++m) { bf16_t* rowp = base + (size_t)(row0 + ai * 128 + m * 16) * ldc + col0;
#pragma unroll
                for (int bj = 0; bj < 2; ++bj) { f32x4 v0 = acc[ai][bj][m][0] + bv[bj][0], v1 = acc[ai][bj][m][1] + bv[bj][1];
                    if (act == 2) {
#pragma unroll
                        for (int e = 0; e < 4; ++e) { const float a0 = fmaxf(v0[e], 0.f), a1 = fmaxf(v1[e], 0.f); v0[e] = a0 * a0; v1[e] = a1 * a1; } }
                    u32x4 w; w.x = pk2(v0[0], v0[1]); w.y = pk2(v0[2], v0[3]); w.z = pk2(v1[0], v1[1]); w.w = pk2(v1[2], v1[3]);
                    *(u32x4*)(rowp + bj * 128) = w; } }
    }
};
struct EpiMerge {
    static constexpr bool PERM = true;
    bf16_t* Z; bf16_t* MRG; const float* gbias;
    __device__ __forceinline__ void operator()(const f32x4 (&acc)[2][2][4][2], const pg8::Unit& u, int wr, int wc, int fr, int fq) const {
        const int n = u.sub >> 1, br = u.sub & 1;
        const int row0 = u.pm * 256 + wr * 64 + fr, col0 = u.pn * 256 + wc * 32 + 8 * fq;
#pragma unroll
        for (int ai = 0; ai < 2; ++ai)
#pragma unroll
            for (int m = 0; m < 4; ++m) { const size_t row = (size_t)(row0 + ai * 128 + m * 16);
                bf16_t* sp = Z + row * LDZ + ZC_SCR + col0; bf16_t* mp = MRG + row * D + col0;
#pragma unroll
                for (int bj = 0; bj < 2; ++bj) { f32x4 v0 = acc[ai][bj][m][0], v1 = acc[ai][bj][m][1];
                    if (!br) {
                        const f32x4 b0 = *(const f32x4*)(gbias + n * 1024 + col0 + bj * 128), b1 = *(const f32x4*)(gbias + n * 1024 + col0 + bj * 128 + 4);
#pragma unroll
                        for (int e = 0; e < 4; ++e) { v0[e] = sigmoidf_(v0[e] + b0[e]); v1[e] = sigmoidf_(v1[e] + b1[e]); }
                        u32x4 w; w.x = pk2(v0[0], v0[1]); w.y = pk2(v0[2], v0[3]); w.z = pk2(v1[0], v1[1]); w.w = pk2(v1[2], v1[3]);
                        *(u32x4*)(sp + bj * 128) = w;
                    } else {
                        const u32x4 s = *(const u32x4*)(sp + bj * 128);
                        v0[0] *= bf_lo(s.x); v0[1] *= bf_hi(s.x); v0[2] *= bf_lo(s.y); v0[3] *= bf_hi(s.y);
                        v1[0] *= bf_lo(s.z); v1[1] *= bf_hi(s.z); v1[2] *= bf_lo(s.w); v1[3] *= bf_hi(s.w);
                        if (n > 0) { const u32x4 q = *(const u32x4*)(mp + bj * 128);
                            v0[0] += bf_lo(q.x); v0[1] += bf_hi(q.x); v0[2] += bf_lo(q.y); v0[3] += bf_hi(q.y);
                            v1[0] += bf_lo(q.z); v1[1] += bf_hi(q.z); v1[2] += bf_lo(q.w); v1[3] += bf_hi(q.w); }
                        u32x4 w; w.x = pk2(v0[0], v0[1]); w.y = pk2(v0[2], v0[3]); w.z = pk2(v1[0], v1[1]); w.w = pk2(v1[2], v1[3]);
                        *(u32x4*)(mp + bj * 128) = w;
                    } } }
    }
};

__device__ __forceinline__ void norm_rows(const float* xsrc, float* xdst, const bf16_t* y, const float* gpost, const float* gpre, bf16_t* hout, int ldh, int nrows, int gw, int NGW, int lane) {
#pragma unroll 1
    for (int m = gw; m < nrows; m += NGW) {
        f32x4 v[4];
        const f32x4* xr = (const f32x4*)(xsrc + (size_t)m * D) + lane;
#pragma unroll
        for (int j = 0; j < 4; ++j) v[j] = xr[64 * j];
        if (y) {
            const u32x2* yr = (const u32x2*)(y + (size_t)m * D) + lane;
            f32x4 yv[4]; float ss = 0.f;
#pragma unroll
            for (int j = 0; j < 4; ++j) { const u32x2 t = yr[64 * j]; yv[j] = (f32x4){bf_lo(t.x), bf_hi(t.x), bf_lo(t.y), bf_hi(t.y)};
                ss += (yv[j][0] * yv[j][0] + yv[j][1] * yv[j][1]) + (yv[j][2] * yv[j][2] + yv[j][3] * yv[j][3]); }
            ss = wave_sum(ss); const float r = 1.f / sqrtf(ss * (1.f / D) + EPS);
            f32x4* xo = (f32x4*)(xdst + (size_t)m * D) + lane;
#pragma unroll
            for (int j = 0; j < 4; ++j) { const f32x4 gp = ((const f32x4*)gpost)[lane + 64 * j]; v[j] = v[j] + yv[j] * r * gp; xo[64 * j] = v[j]; }
        }
        if (hout) {
            float ss = 0.f;
#pragma unroll
            for (int j = 0; j < 4; ++j) ss += (v[j][0] * v[j][0] + v[j][1] * v[j][1]) + (v[j][2] * v[j][2] + v[j][3] * v[j][3]);
            ss = wave_sum(ss); const float r = 1.f / sqrtf(ss * (1.f / D) + EPS);
            u32x2* ho = (u32x2*)(hout + (size_t)m * ldh) + lane;
#pragma unroll
            for (int j = 0; j < 4; ++j) { const f32x4 gp = ((const f32x4*)gpre)[lane + 64 * j]; const f32x4 o = v[j] * r * gp; u32x2 w; w.x = pk2(o[0], o[1]); w.y = pk2(o[2], o[3]); ho[64 * j] = w; }
        }
    }
}

__device__ __forceinline__ void tr_item(const float* W, int ldw, int col0, bf16_t* WT, int ldt, int row0, int nblk, LAS float* scr, int item, int lane) {
    const int kb = item / nblk, nb = item % nblk, k0 = 64 * kb, n0 = 32 * nb;
#pragma unroll 8
    for (int i = 0; i < 32; ++i) { const int kk = 2 * i + (lane >> 5); scr[kk * 33 + (lane & 31)] = W[(size_t)(k0 + kk) * ldw + col0 + n0 + (lane & 31)]; }
    LDS_FENCE();
    const int c = lane & 7;
#pragma unroll
    for (int j = 0; j < 4; ++j) { const int n = (lane >> 3) + 8 * j; const LAS float* s = scr + (8 * c) * 33 + n;
        u32x4 o; o.x = pk2(s[0 * 33], s[1 * 33]); o.y = pk2(s[2 * 33], s[3 * 33]); o.z = pk2(s[4 * 33], s[5 * 33]); o.w = pk2(s[6 * 33], s[7 * 33]);
        *(u32x4*)(WT + (size_t)(row0 + n0 + n) * ldt + k0 + 8 * c) = o; }
    LDS_FENCE();
}
__device__ __forceinline__ int small_src(int i) { return i < 8 ? 1536 + i : (i < 12 ? 3080 + (i - 8) : 3084 + (i - 12)); }
struct LayerW { const float *w_in, *b_in, *w_branch, *w_out, *w_xq, *w_xkv, *w_xo, *w_ff1, *w_ff2; };
__device__ __forceinline__ void convert_weights(const LayerW& L, unsigned char* ws, LAS unsigned char* lds, int gw, int NGW, int wave, int lane, int gtid, int NGT) {
    bf16_t* Win_t = (bf16_t*)(ws + WS_WIN); bf16_t* Wm_t = (bf16_t*)(ws + WS_WM); bf16_t* Wo_t = (bf16_t*)(ws + WS_WO); bf16_t* Wxq_t = (bf16_t*)(ws + WS_WXQ);
    bf16_t* Wxkv_t = (bf16_t*)(ws + WS_WXKV); bf16_t* Wxo_t = (bf16_t*)(ws + WS_WXO); bf16_t* W1_t = (bf16_t*)(ws + WS_W1); bf16_t* W2_t = (bf16_t*)(ws + WS_W2);
    float* biasz = (float*)(ws + WS_BIASZ);
    LAS float* scr = (LAS float*)(lds + wave * 16384);
    constexpr int NIT = 768 + 768 + 256 + 512 + 1536 + 3 * 256 + 512 + 512 + 1024 + 512 + 2048 + 2048;
#pragma unroll 1
    for (int it = gw; it < NIT; it += NGW) {
        int r = it;
        if (r < 768) { tr_item(L.w_in, DIN, 0, Win_t, 1024, 0, 48, scr, r, lane); continue; } r -= 768;
        if (r < 768) { tr_item(L.w_in, DIN, 1544, Win_t, 1024, 1536, 48, scr, r, lane); continue; } r -= 768;
        if (r < 256) { tr_item(L.w_in, DIN, 3088, Win_t, 1024, 3072, 16, scr, r, lane); continue; } r -= 256;
        if (r < 512) { tr_item(L.w_in, DIN, 3600, Win_t, 1024, 3584, 32, scr, r, lane); continue; } r -= 512;
        if (r < 1536) { tr_item(L.w_in, DIN, 4624, Wm_t, 1024, 0, 96, scr, r, lane); continue; } r -= 1536;
        if (r < 768) { const int n = r >> 8; tr_item(L.w_branch + (size_t)n * 512 * 1024, 1024, 0, Wm_t, 1024, 3072 + n * 1024, 32, scr, r & 255, lane); continue; } r -= 768;
        if (r < 512) { tr_item(L.w_out, 1024, 0, Wo_t, 1024, 0, 32, scr, r, lane); continue; } r -= 512;
        if (r < 512) { tr_item(L.w_xq, 1024, 0, Wxq_t, 1024, 0, 32, scr, r, lane); continue; } r -= 512;
        if (r < 1024) { tr_item(L.w_xkv, 2048, 0, Wxkv_t, 1024, 0, 64, scr, r, lane); continue; } r -= 1024;
        if (r < 512) { tr_item(L.w_xo, 1024, 0, Wxo_t, 1024, 0, 32, scr, r, lane); continue; } r -= 512;
        if (r < 2048) { tr_item(L.w_ff1, 4096, 0, W1_t, 1024, 0, 128, scr, r, lane); continue; } r -= 2048;
        tr_item(L.w_ff2, 1024, 0, W2_t, 4096, 0, 32, scr, r, lane);
    }
    const u32x4 z4 = {0u, 0u, 0u, 0u};
#pragma unroll 1
    for (int i = gtid; i < 3072 * 64; i += NGT) { const int row = i >> 6, c = i & 63; *(u32x4*)(Wm_t + (size_t)(3072 + row) * 1024 + 512 + c * 8) = z4; }
#pragma unroll 1
    for (int i = gtid; i < 240 * 128; i += NGT) { const int row = i >> 7, c = i & 127; *(u32x4*)(Win_t + (size_t)(4624 + row) * 1024 + c * 8) = z4; }
#pragma unroll 1
    for (int i = gtid; i < 16 * 1024; i += NGT) { const int j = i >> 10, k = i & 1023; Win_t[(size_t)(4608 + j) * 1024 + k] = f2bf(L.w_in[(size_t)k * DIN + small_src(j)]); }
#pragma unroll 1
    for (int c = gtid; c < 4864; c += NGT) {
        float v;
        if (c < 1536) v = L.b_in[c]; else if (c < 3072) v = L.b_in[1544 + c - 1536]; else if (c < 3584) v = L.b_in[3088 + c - 3072];
        else if (c < 4608) v = L.b_in[3600 + c - 3584]; else if (c < 4624) v = L.b_in[small_src(c - 4608)]; else v = 0.f;
        biasz[c] = v;
    }
}

__device__ __forceinline__ void fox_item(LAS unsigned char* lds, bf16_t* Z, int b, int h, int qb, int tid) {
    asm volatile("" : "+v"(tid));
    const int lane = tid & 63, w = __builtin_amdgcn_readfirstlane(tid >> 6), fr = lane & 15, fq = lane >> 4;
    LAS float* Fs = (LAS float*)lds;
    LAS float* wsum = (LAS float*)(lds + 8192);
    LAS bf16_t* Ks = (LAS bf16_t*)(lds + 8448);
    LAS bf16_t* Vt = Ks + 64 * 72;
    LAS bf16_t* Ps = Vt + 64 * 72 + w * 16 * 72;
    const int q0 = qb * 128, q1 = q0 + 128;
    const size_t rowbase = (size_t)b * SEQ;
    {
        float lf[4]; float run = 0.f;
#pragma unroll
        for (int i = 0; i < 4; ++i) { const int t = 4 * tid + i; float v = 0.f; if (t < q1) v = logsigmoidf_(bf2f(Z[(rowbase + t) * LDZ + ZC_SM + h])); run += v; lf[i] = run; }
        float sc = run;
#pragma unroll
        for (int o = 1; o < 64; o <<= 1) { const float nb = __shfl_up(sc, o); if (lane >= o) sc += nb; }
        if (lane == 63) wsum[w] = sc;
        __syncthreads();
        float base = 0.f;
        for (int i = 0; i < w; ++i) base += wsum[i];
        const float excl = base + sc - run;
#pragma unroll
        for (int i = 0; i < 4; ++i) Fs[4 * tid + i] = excl + lf[i];
        __syncthreads();
    }
    const int qrow = q0 + w * 16;
    bf16x8 qf[2];
#pragma unroll
    for (int ks = 0; ks < 2; ++ks) qf[ks] = *(const bf16x8*)(Z + (rowbase + qrow + fr) * LDZ + ZC_FQ + h * 64 + ks * 32 + fq * 8);
    float Ft[4], mrow[4], lrow[4];
#pragma unroll
    for (int j = 0; j < 4; ++j) { Ft[j] = Fs[qrow + fq * 4 + j]; mrow[j] = -INFINITY; lrow[j] = 0.f; }
    f32x4 O[4];
#pragma unroll
    for (int nt = 0; nt < 4; ++nt) O[nt] = (f32x4){0.f, 0.f, 0.f, 0.f};
    const int nkt = q1 / 64;
    for (int kt = 0; kt < nkt; ++kt) {
        __syncthreads();
        {   const int key = tid >> 3, dc = tid & 7;
            const bf16_t* src = Z + (rowbase + kt * 64 + key) * LDZ + h * 64 + dc * 8;
            const u32x4 kv = *(const u32x4*)(src + ZC_FK); const u32x4 vv = *(const u32x4*)(src + ZC_FV);
            *(LAS u32x4*)(Ks + key * 72 + dc * 8) = kv;
            LAS bf16_t* vp = Vt + (dc * 8) * 72 + key;
            vp[0 * 72] = (bf16_t)(vv.x & 0xffffu); vp[1 * 72] = (bf16_t)(vv.x >> 16); vp[2 * 72] = (bf16_t)(vv.y & 0xffffu); vp[3 * 72] = (bf16_t)(vv.y >> 16);
            vp[4 * 72] = (bf16_t)(vv.z & 0xffffu); vp[5 * 72] = (bf16_t)(vv.z >> 16); vp[6 * 72] = (bf16_t)(vv.w & 0xffffu); vp[7 * 72] = (bf16_t)(vv.w >> 16);
        }
        __syncthreads();
        if (kt * 64 <= qrow + 15) {
            f32x4 S[4];
#pragma unroll
            for (int nt = 0; nt < 4; ++nt) { S[nt] = (f32x4){0.f, 0.f, 0.f, 0.f};
#pragma unroll
                for (int ks = 0; ks < 2; ++ks) S[nt] = MFMA16(qf[ks], frag(Ks, 72, nt * 16, ks * 32, lane), S[nt]); }
            float mx[4] = {-INFINITY, -INFINITY, -INFINITY, -INFINITY};
#pragma unroll
            for (int nt = 0; nt < 4; ++nt) { const int key = kt * 64 + nt * 16 + fr; const float Fk = Fs[key];
#pragma unroll
                for (int j = 0; j < 4; ++j) { const int t = qrow + fq * 4 + j; float s = S[nt][j] * 0.125f + Ft[j] - Fk; if (key > t) s = -INFINITY; S[nt][j] = s; mx[j] = fmaxf(mx[j], s); } }
#pragma unroll
            for (int j = 0; j < 4; ++j) {
                float v = mx[j];
                v = fmaxf(v, __shfl_xor(v, 1)); v = fmaxf(v, __shfl_xor(v, 2)); v = fmaxf(v, __shfl_xor(v, 4)); v = fmaxf(v, __shfl_xor(v, 8));
                const float mnew = fmaxf(mrow[j], v); const float alpha = __expf(mrow[j] - mnew); mrow[j] = mnew; lrow[j] *= alpha;
#pragma unroll
                for (int nt = 0; nt < 4; ++nt) O[nt][j] *= alpha;
            }
#pragma unroll
            for (int nt = 0; nt < 4; ++nt)
#pragma unroll
                for (int j = 0; j < 4; ++j) { const float p = __expf(S[nt][j] - mrow[j]); lrow[j] += p; Ps[(fq * 4 + j) * 72 + nt * 16 + fr] = f2bf(p); }
            LDS_FENCE();
#pragma unroll
            for (int ks = 0; ks < 2; ++ks) { const bf16x8 pf = frag(Ps, 72, 0, ks * 32, lane);
#pragma unroll
                for (int nt = 0; nt < 4; ++nt) O[nt] = MFMA16(pf, frag(Vt, 72, nt * 16, ks * 32, lane), O[nt]); }
            LDS_FENCE();
        }
    }
#pragma unroll
    for (int j = 0; j < 4; ++j) { float v = lrow[j]; v += __shfl_xor(v, 1); v += __shfl_xor(v, 2); v += __shfl_xor(v, 4); v += __shfl_xor(v, 8); lrow[j] = 1.f / v; }
#pragma unroll
    for (int nt = 0; nt < 4; ++nt)
#pragma unroll
        for (int j = 0; j < 4; ++j) Z[(rowbase + qrow + fq * 4 + j) * LDZ + ZC_FQ + h * 64 + nt * 16 + fr] = f2bf(O[nt][j] * lrow[j]);
    __syncthreads();
}

__device__ __forceinline__ void mlstm_item(LAS unsigned char* lds, bf16_t* Z, const float* convw, const float* mg, int b, int h, int tid) {
    asm volatile("" : "+v"(tid));
    const int lane = tid & 63, w = __builtin_amdgcn_readfirstlane(tid >> 6), fr = lane & 15, fq = lane >> 4;
    LAS bf16_t* Qs = (LAS bf16_t*)lds;
    LAS bf16_t* Ks = Qs + 64 * 136;
    LAS bf16_t* KWt = Ks + 64 * 136;
    LAS bf16_t* Vt = KWt + 128 * 72;
    LAS bf16_t* Ct = Vt + 144 * 72;
    LAS bf16_t* Ps = Ct + 144 * 136;
    LAS float* GA = (LAS float*)(Ps + 64 * 72);
    LAS float* GM = GA + 64; LAS float* WI = GA + 128; LAS float* EN = GA + 192; LAS float* WS = GA + 256; LAS float* SC = GA + 320;
    LAS float* SSQ = GA + 336;
    LAS float* CW = GA + 464;
    const size_t rowbase = (size_t)b * SEQ;
    for (int i = tid; i < 144 * 136 / 2; i += 512) ((LAS unsigned*)Ct)[i] = 0u;
    for (int i = tid; i < 16 * 72; i += 512) Vt[128 * 72 + i] = (i < 72) ? (bf16_t)0x3F80 : (bf16_t)0;
    for (int i = tid; i < 1024; i += 512) { const int j = i >> 8, c = i & 255; CW[i] = convw[j * 1024 + (c < 128 ? h * 128 + c : 512 + h * 128 + (c - 128))]; }
    f32x4 Cacc[9];
#pragma unroll
    for (int nt = 0; nt < 9; ++nt) Cacc[nt] = (f32x4){0.f, 0.f, 0.f, 0.f};
    float mprev = 0.f;
    const int dc = tid & 15;
    for (int ch = 0; ch < SEQ / 64; ++ch) {
        const int t0 = ch * 64;
        if (w == 0) {
            const size_t row = rowbase + t0 + lane;
            const float ip = bf2f(Z[row * LDZ + ZC_SM + 8 + h]), fp = bf2f(Z[row * LDZ + ZC_SM + 12 + h]);
            float bc = logsigmoidf_(fp);
#pragma unroll
            for (int o = 1; o < 64; o <<= 1) { const float nb = __shfl_up(bc, o); if (lane >= o) bc += nb; }
            const float av = ip - bc;
            float gm = av;
#pragma unroll
            for (int o = 1; o < 64; o <<= 1) { const float nb = __shfl_up(gm, o); if (lane >= o) gm = fmaxf(gm, nb); }
            const float mm = fmaxf(mprev, gm), mt = bc + mm;
            GA[lane] = av; GM[lane] = mm; WI[lane] = __expf(mprev - mm); EN[lane] = __expf(-mt);
            const float mm63 = __shfl(mm, 63), b63 = __shfl(bc, 63);
            WS[lane] = __expf(av - mm63);
            if (lane == 0) SC[0] = __expf(mprev - mm63);
            mprev = b63 + mm63;
        }
        __syncthreads();
#pragma unroll 1
        for (int i = 0; i < 2; ++i) {
            const int t = (tid >> 4) + 32 * i; const int tg = t0 + t;
            const size_t row = rowbase + tg;
            float aq[8], ak[8];
#pragma unroll
            for (int e = 0; e < 8; ++e) { aq[e] = 0.f; ak[e] = 0.f; }
#pragma unroll
            for (int j = 0; j < 4; ++j) {
                if (tg - 3 + j >= 0) {
                    const bf16_t* src = Z + (row - 3 + j) * LDZ + h * 128 + dc * 8;
                    const u32x4 rq = *(const u32x4*)(src + ZC_MQ), rk = *(const u32x4*)(src + ZC_MK);
                    const f32x4 wq0 = *(const LAS f32x4*)(CW + j * 256 + dc * 8), wq1 = *(const LAS f32x4*)(CW + j * 256 + dc * 8 + 4);
                    const f32x4 wk0 = *(const LAS f32x4*)(CW + j * 256 + 128 + dc * 8), wk1 = *(const LAS f32x4*)(CW + j * 256 + 128 + dc * 8 + 4);
                    aq[0] += wq0[0] * bf_lo(rq.x); aq[1] += wq0[1] * bf_hi(rq.x); aq[2] += wq0[2] * bf_lo(rq.y); aq[3] += wq0[3] * bf_hi(rq.y);
                    aq[4] += wq1[0] * bf_lo(rq.z); aq[5] += wq1[1] * bf_hi(rq.z); aq[6] += wq1[2] * bf_lo(rq.w); aq[7] += wq1[3] * bf_hi(rq.w);
                    ak[0] += wk0[0] * bf_lo(rk.x); ak[1] += wk0[1] * bf_hi(rk.x); ak[2] += wk0[2] * bf_lo(rk.y); ak[3] += wk0[3] * bf_hi(rk.y);
                    ak[4] += wk1[0] * bf_lo(rk.z); ak[5] += wk1[1] * bf_hi(rk.z); ak[6] += wk1[2] * bf_lo(rk.w); ak[7] += wk1[3] * bf_hi(rk.w);
                }
            }
            const float wst = WS[t];
#pragma unroll
            for (int e = 0; e < 8; ++e) { aq[e] = aq[e] * sigmoidf_(aq[e]); ak[e] = ak[e] * sigmoidf_(ak[e]) * 0.08838834764831845f; }
            u32x4 oq, ok;
            oq.x = pk2(aq[0], aq[1]); oq.y = pk2(aq[2], aq[3]); oq.z = pk2(aq[4], aq[5]); oq.w = pk2(aq[6], aq[7]);
            ok.x = pk2(ak[0], ak[1]); ok.y = pk2(ak[2], ak[3]); ok.z = pk2(ak[4], ak[5]); ok.w = pk2(ak[6], ak[7]);
            *(LAS u32x4*)(Qs + t * 136 + dc * 8) = oq; *(LAS u32x4*)(Ks + t * 136 + dc * 8) = ok;
#pragma unroll
            for (int e = 0; e < 8; ++e) KWt[(dc * 8 + e) * 72 + t] = f2bf(ak[e] * wst);
            const u32x4 rv = *(const u32x4*)(Z + row * LDZ + ZC_MV + h * 128 + dc * 8);
            LAS bf16_t* vp = Vt + (dc * 8) * 72 + t;
            vp[0 * 72] = (bf16_t)(rv.x & 0xffffu); vp[1 * 72] = (bf16_t)(rv.x >> 16); vp[2 * 72] = (bf16_t)(rv.y & 0xffffu); vp[3 * 72] = (bf16_t)(rv.y >> 16);
            vp[4 * 72] = (bf16_t)(rv.z & 0xffffu); vp[5 * 72] = (bf16_t)(rv.z >> 16); vp[6 * 72] = (bf16_t)(rv.w & 0xffffu); vp[7 * 72] = (bf16_t)(rv.w >> 16);
        }
        __syncthreads();
        {   const int mt = w >> 1;
#pragma unroll
            for (int x = 0; x < 2; ++x) { const int nt = (w & 1) * 2 + x;
                f32x4 acc = (f32x4){0.f, 0.f, 0.f, 0.f};
#pragma unroll
                for (int ks = 0; ks < 4; ++ks) acc = MFMA16(frag(Qs, 136, mt * 16, ks * 32, lane), frag(Ks, 136, nt * 16, ks * 32, lane), acc);
                const int s = nt * 16 + fr; const float as = GA[s];
#pragma unroll
                for (int j = 0; j < 4; ++j) { const int t = mt * 16 + fq * 4 + j; const float p = (s <= t) ? acc[j] * __expf(as - GM[t]) : 0.f; Ps[t * 72 + s] = f2bf(p); }
            }
        }
        __syncthreads();
        {   const int mt = w & 3, half = w >> 2;
            f32x4 Hacc[5];
#pragma unroll
            for (int x = 0; x < 5; ++x) { const int nt = (x < 4) ? half * 4 + x : 8;
                f32x4 acc = (f32x4){0.f, 0.f, 0.f, 0.f};
#pragma unroll
                for (int ks = 0; ks < 4; ++ks) acc = MFMA16(frag(Qs, 136, mt * 16, ks * 32, lane), frag(Ct, 136, nt * 16, ks * 32, lane), acc);
#pragma unroll
                for (int j = 0; j < 4; ++j) acc[j] *= WI[mt * 16 + fq * 4 + j];
#pragma unroll
                for (int ks = 0; ks < 2; ++ks) acc = MFMA16(frag(Ps, 72, mt * 16, ks * 32, lane), frag(Vt, 72, nt * 16, ks * 32, lane), acc);
                Hacc[x] = acc; }
            float ssq[4];
#pragma unroll
            for (int j = 0; j < 4; ++j) { const float den = __shfl(Hacc[4][j], lane & 48); const float dn = fmaxf(fabsf(den), EN[mt * 16 + fq * 4 + j]); const float inv = 1.f / dn;
                float s = 0.f;
#pragma unroll
                for (int x = 0; x < 4; ++x) { Hacc[x][j] *= inv; s += Hacc[x][j] * Hacc[x][j]; }
                s += __shfl_xor(s, 1); s += __shfl_xor(s, 2); s += __shfl_xor(s, 4); s += __shfl_xor(s, 8); ssq[j] = s; }
            if (fr == 0) {
#pragma unroll
                for (int j = 0; j < 4; ++j) SSQ[half * 64 + mt * 16 + fq * 4 + j] = ssq[j]; }
            __syncthreads();
#pragma unroll
            for (int j = 0; j < 4; ++j) { const int t = mt * 16 + fq * 4 + j; const float tot = SSQ[t] + SSQ[64 + t]; const float r = 1.f / sqrtf(tot * (1.f / 128.f) + EPS);
#pragma unroll
                for (int x = 0; x < 4; ++x) { const int e = (half * 4 + x) * 16 + fr; bf16_t* p = Z + (rowbase + t0 + t) * LDZ + ZC_MO + h * 128 + e;
                    const float hm = Hacc[x][j] * r * mg[h * 128 + e]; *p = f2bf(sigmoidf_(bf2f(*p)) * hm); } }
        }
        {   const float decay = SC[0];
#pragma unroll
            for (int nt = 0; nt < 9; ++nt) Cacc[nt] = Cacc[nt] * decay;
#pragma unroll
            for (int ks = 0; ks < 2; ++ks) { const bf16x8 af = frag(KWt, 72, w * 16, ks * 32, lane);
#pragma unroll
                for (int nt = 0; nt < 9; ++nt) Cacc[nt] = MFMA16(af, frag(Vt, 72, nt * 16, ks * 32, lane), Cacc[nt]); }
#pragma unroll
            for (int nt = 0; nt < 9; ++nt) { u32x2 o; o.x = pk2(Cacc[nt][0], Cacc[nt][1]); o.y = pk2(Cacc[nt][2], Cacc[nt][3]);
                *(LAS u32x2*)(Ct + (nt * 16 + fr) * 136 + w * 16 + fq * 4) = o; }
        }
        __syncthreads();
    }
}

__device__ __forceinline__ void gmlp_item(LAS unsigned char* lds, bf16_t* Z, const float* gnorm, const float* wsg, const float* bsg, int b, int sp, int g, int tid) {
    asm volatile("" : "+v"(tid));
    const int lane = tid & 63, w = __builtin_amdgcn_readfirstlane(tid >> 6), fr = lane & 15, fq = lane >> 4;
    LAS bf16_t* As = (LAS bf16_t*)lds;
    LAS bf16_t* Vt = As + 128 * 136;
    const size_t rowbase = (size_t)b * SEQ + sp * 128;
#pragma unroll
    for (int i = 0; i < 8; ++i) { const int idx = tid + 512 * i; const int t = idx >> 5, s4 = (idx & 31) * 4;
        f32x4 wv = *(const f32x4*)(wsg + t * 128 + s4); if ((t >> 6) < (s4 >> 6)) wv = (f32x4){0.f, 0.f, 0.f, 0.f};
        u32x2 o; o.x = pk2(wv[0], wv[1]); o.y = pk2(wv[2], wv[3]); *(LAS u32x2*)(As + t * 136 + s4) = o; }
    for (int tt = 0; tt < 16; ++tt) { const int t = w * 16 + tt;
        const u32x4 raw = *(const u32x4*)(Z + (rowbase + t) * LDZ + ZC_GV + lane * 8);
        float x[8]; x[0] = bf_lo(raw.x); x[1] = bf_hi(raw.x); x[2] = bf_lo(raw.y); x[3] = bf_hi(raw.y); x[4] = bf_lo(raw.z); x[5] = bf_hi(raw.z); x[6] = bf_lo(raw.w); x[7] = bf_hi(raw.w);
        float s = 0.f;
#pragma unroll
        for (int e = 0; e < 8; ++e) { x[e] = gelu_tanh(x[e]); s += x[e]; }
        const float mean = wave_sum(s) * (1.f / 512.f); float q = 0.f;
#pragma unroll
        for (int e = 0; e < 8; ++e) { x[e] -= mean; q += x[e] * x[e]; }
        const float rstd = 1.f / sqrtf(wave_sum(q) * (1.f / 512.f) + EPS);
        if (fq == g) {
#pragma unroll
            for (int e = 0; e < 8; ++e) Vt[(fr * 8 + e) * 136 + t] = f2bf(x[e] * rstd * gnorm[lane * 8 + e]); }
    }
    __syncthreads();
    f32x4 acc[8];
#pragma unroll
    for (int nt = 0; nt < 8; ++nt) acc[nt] = (f32x4){0.f, 0.f, 0.f, 0.f};
    const int kmax = (w < 4) ? 2 : 4;
    for (int ks = 0; ks < kmax; ++ks) { const bf16x8 af = frag(As, 136, w * 16, ks * 32, lane);
#pragma unroll
        for (int nt = 0; nt < 8; ++nt) acc[nt] = MFMA16(af, frag(Vt, 136, nt * 16, ks * 32, lane), acc[nt]); }
#pragma unroll
    for (int j = 0; j < 4; ++j) { const int t = w * 16 + fq * 4 + j; const float bt = bsg[t];
#pragma unroll
        for (int nt = 0; nt < 8; ++nt) { bf16_t* p = Z + (rowbase + t) * LDZ + ZC_GU + g * 128 + nt * 16 + fr; *p = f2bf(gelu_tanh(bf2f(*p)) * (acc[nt][j] + bt)); } }
    __syncthreads();
}

__device__ __forceinline__ void xattn_item(LAS unsigned char* lds, const bf16_t* Q, const bf16_t* KV, bf16_t* Oo, int b, int h, int qb, int tid) {
    asm volatile("" : "+v"(tid));
    const int lane = tid & 63, w = __builtin_amdgcn_readfirstlane(tid >> 6), fr = lane & 15, fq = lane >> 4;
    LAS bf16_t* Ks = (LAS bf16_t*)lds;
    LAS bf16_t* Vt = Ks + 64 * 264;
    LAS bf16_t* Ps = Vt + 256 * 72 + w * 16 * 264;
    const size_t qrow = (size_t)b * SEQ + qb * 128 + w * 16;
    bf16x8 qf[8];
#pragma unroll
    for (int ks = 0; ks < 8; ++ks) qf[ks] = *(const bf16x8*)(Q + (qrow + fr) * D + h * 256 + ks * 32 + fq * 8);
    f32x4 S[16];
#pragma unroll
    for (int kc = 0; kc < 4; ++kc) {
        __syncthreads();
#pragma unroll
        for (int i = 0; i < 4; ++i) { const int idx = tid + 512 * i; const int key = idx >> 5, dcc = idx & 31;
            *(LAS u32x4*)(Ks + key * 264 + dcc * 8) = *(const u32x4*)(KV + (size_t)(b * 256 + kc * 64 + key) * 2048 + h * 256 + dcc * 8); }
        __syncthreads();
#pragma unroll
        for (int nt = 0; nt < 4; ++nt) { f32x4 acc = (f32x4){0.f, 0.f, 0.f, 0.f};
#pragma unroll
            for (int ks = 0; ks < 8; ++ks) acc = MFMA16(qf[ks], frag(Ks, 264, nt * 16, ks * 32, lane), acc);
            S[kc * 4 + nt] = acc; }
    }
    float inv[4];
#pragma unroll
    for (int j = 0; j < 4; ++j) {
        float mx = -INFINITY;
#pragma unroll
        for (int i = 0; i < 16; ++i) mx = fmaxf(mx, S[i][j]);
        mx = fmaxf(mx, __shfl_xor(mx, 1)); mx = fmaxf(mx, __shfl_xor(mx, 2)); mx = fmaxf(mx, __shfl_xor(mx, 4)); mx = fmaxf(mx, __shfl_xor(mx, 8));
        float sum = 0.f;
#pragma unroll
        for (int i = 0; i < 16; ++i) { const float p = __expf((S[i][j] - mx) * 0.0625f); sum += p; Ps[(fq * 4 + j) * 264 + i * 16 + fr] = f2bf(p); }
        sum += __shfl_xor(sum, 1); sum += __shfl_xor(sum, 2); sum += __shfl_xor(sum, 4); sum += __shfl_xor(sum, 8);
        inv[j] = 1.f / sum;
    }
    f32x4 O[16];
#pragma unroll
    for (int nt = 0; nt < 16; ++nt) O[nt] = (f32x4){0.f, 0.f, 0.f, 0.f};
#pragma unroll
    for (int kc = 0; kc < 4; ++kc) {
        __syncthreads();
#pragma unroll
        for (int i = 0; i < 4; ++i) { const int idx = tid + 512 * i; const int key = idx >> 5, dcc = idx & 31;
            const u32x4 vv = *(const u32x4*)(KV + (size_t)(b * 256 + kc * 64 + key) * 2048 + 1024 + h * 256 + dcc * 8);
            LAS bf16_t* vp = Vt + (dcc * 8) * 72 + key;
            vp[0 * 72] = (bf16_t)(vv.x & 0xffffu); vp[1 * 72] = (bf16_t)(vv.x >> 16); vp[2 * 72] = (bf16_t)(vv.y & 0xffffu); vp[3 * 72] = (bf16_t)(vv.y >> 16);
            vp[4 * 72] = (bf16_t)(vv.z & 0xffffu); vp[5 * 72] = (bf16_t)(vv.z >> 16); vp[6 * 72] = (bf16_t)(vv.w & 0xffffu); vp[7 * 72] = (bf16_t)(vv.w >> 16); }
        __syncthreads();
#pragma unroll
        for (int ks = 0; ks < 2; ++ks) { const bf16x8 pf = frag(Ps, 264, 0, kc * 64 + ks * 32, lane);
#pragma unroll
            for (int nt = 0; nt < 16; ++nt) O[nt] = MFMA16(pf, frag(Vt, 72, nt * 16, ks * 32, lane), O[nt]); }
    }
#pragma unroll
    for (int nt = 0; nt < 16; ++nt)
#pragma unroll
        for (int j = 0; j < 4; ++j) Oo[(qrow + fq * 4 + j) * D + h * 256 + nt * 16 + fr] = f2bf(O[nt][j] * inv[j]);
    __syncthreads();
}

struct Args { const float* in[17]; float* out; unsigned char* ws; int ph_lo, ph_hi; };
__global__ void __launch_bounds__(512, 2) fwd_kernel(Args a) {
    extern __shared__ __attribute__((aligned(16))) unsigned char lds_raw[];
    LAS unsigned char* lds = (LAS unsigned char*)lds_raw;
    constexpr int G = 256; const int bx = blockIdx.x;
    cg::grid_group grid = cg::this_grid();
    for (int ph = a.ph_lo; ph < a.ph_hi; ++ph) {
    if (ph != a.ph_lo) grid.sync();
    int tid = threadIdx.x; asm volatile("" : "+v"(tid));
    unsigned char* ws = a.ws; asm volatile("" : "+s"(ws));
    const int lane = tid & 63, wave = __builtin_amdgcn_readfirstlane(tid >> 6);
    const int gw = bx * 8 + wave, NGW = G * 8, gtid = bx * 512 + tid, NGT = G * 512;
    bf16_t* ZH = (bf16_t*)(ws + WS_ZH); bf16_t* MRG = (bf16_t*)(ws + WS_MRG); bf16_t* KVb = (bf16_t*)(ws + WS_KV); bf16_t* MEMN = (bf16_t*)(ws + WS_MEMN);
    bf16_t* Y_A = ZH;
    bf16_t* H2A = (bf16_t*)(ws + WS_ZH + 64 * MiB);
    bf16_t* QB = (bf16_t*)(ws + WS_ZH + 128 * MiB);
    bf16_t* OB = (bf16_t*)(ws + WS_ZH + 192 * MiB);
    bf16_t* H2B = ZH;
    bf16_t* HID = (bf16_t*)(ws + WS_ZH + 64 * MiB);
    bf16_t* Win_t = (bf16_t*)(ws + WS_WIN); bf16_t* Wm_t = (bf16_t*)(ws + WS_WM); bf16_t* Wo_t = (bf16_t*)(ws + WS_WO); bf16_t* Wxq_t = (bf16_t*)(ws + WS_WXQ);
    bf16_t* Wxkv_t = (bf16_t*)(ws + WS_WXKV); bf16_t* Wxo_t = (bf16_t*)(ws + WS_WXO); bf16_t* W1_t = (bf16_t*)(ws + WS_W1); bf16_t* W2_t = (bf16_t*)(ws + WS_W2);
    const float* biasz = (const float*)(ws + WS_BIASZ);
    const float* x_in = a.in[0]; const float* mem = a.in[1]; const float* norms = a.in[2];
    float* xout = a.out;
    {
        if (ph == 0) {
            LayerW L{a.in[3], a.in[4], a.in[10], a.in[11], a.in[12], a.in[13], a.in[14], a.in[15], a.in[16]};
            convert_weights(L, ws, lds, gw, NGW, wave, lane, gtid, NGT);
            norm_rows(x_in, nullptr, nullptr, nullptr, norms + 0 * D, ZH + HCOL, LDZ, MTOK, gw, NGW, lane);
            continue;
        }
        const int l = (ph - 1) / 12, k = (ph - 1) % 12 + 1;
        const float* gl = norms + (size_t)l * 7 * D;
        if (k == 1 || k == 4 || k == 6 || k == 8 || k == 10 || k == 11) {
            pg8::Gemm g; USched S; EpiStore E;
            S.G = G; S.c = bx; S.mode = 0; S.nM1 = 0; S.nN1 = 0; S.a1off = 0; S.b1off = 0; S.a0col = 0; S.nM0 = 128; S.nN0 = 4;
            E.O1 = nullptr; E.ldc1 = 0; E.bias = nullptr; E.act = 0; E.ldc0 = D;
            g.lda = D; g.K = D;
            if (k == 1) { g.A = ZH; g.Bt = Win_t; g.lda = LDZ; S.nN0 = 19; S.a0col = HCOL; E.O0 = ZH; E.ldc0 = LDZ; E.bias = biasz; }
            else if (k == 4) { g.A = MRG; g.Bt = Wo_t; E.O0 = Y_A; }
            else if (k == 6) { g.A = H2A; g.Bt = Wxq_t; S.mode = 1; S.nM1 = 16; S.nN1 = 8; S.a1off = (long)(MEMN - H2A); S.b1off = (long)(Wxkv_t - Wxq_t); E.O0 = QB; E.O1 = KVb; E.ldc1 = 2048; }
            else if (k == 8) { g.A = OB; g.Bt = Wxo_t; E.O0 = MRG; }
            else if (k == 10) { g.A = H2B; g.Bt = W1_t; S.nN0 = 16; E.O0 = HID; E.ldc0 = DFF; E.act = 2; }
            else { g.A = HID; g.Bt = W2_t; g.lda = DFF; g.K = DFF; E.O0 = MRG; }
            S.lda = g.lda; S.K = g.K;

#ifndef NO_GEMM
pg8::gemm_phase<EpiStore, USched, true>(lds, g, S, E, tid);
#endif

        } else if (k == 3) {
            pg8::Gemm g; g.A = ZH; g.Bt = Wm_t; g.lda = LDZ; g.K = D;
            USched S; S.G = G; S.c = bx; S.mode = 2; S.nM0 = 128; S.nN0 = 4; S.nM1 = 0; S.nN1 = 0; S.a1off = 0; S.b1off = 0; S.a0col = 0; S.lda = LDZ; S.K = D;
            EpiMerge E; E.Z = ZH; E.MRG = MRG; E.gbias = a.in[4] + (size_t)l * DIN + 4624;

#ifndef NO_MERGE
pg8::gemm_phase<EpiMerge, USched, true>(lds, g, S, E, tid);
#endif

        } else if (k == 2) {
            unsigned* ctr = (unsigned*)(ws + WS_CTL) + 64 * (l + 1);
            LAS int* qslot = (LAS int*)(lds + LDS_BYTES - 64);
            const float* convw = a.in[5] + (size_t)l * 4 * 1024; const float* mg = a.in[6] + (size_t)l * 512; const float* gnorm = a.in[7] + (size_t)l * 512;
            const float* gws = a.in[8] + (size_t)l * 4 * 128 * 128; const float* gbs = a.in[9] + (size_t)l * 4 * 128;
            for (;;) {
                __syncthreads();
                if (tid == 0) *qslot = (int)atomicAdd(ctr, 1u);
                __syncthreads();
                const int it = __builtin_amdgcn_readfirstlane(*qslot);
                if (it >= 64 + 2048 + 1024) break;
                if (it < 64) {
#ifndef NO_MLSTM
mlstm_item(lds, ZH, convw, mg, it >> 2, it & 3, tid);
#endif
}
                else if (it < 64 + 2048) { const int r = it - 64; const int qb = 15 - (r >> 7), bh = r & 127;
#ifndef NO_FOX
fox_item(lds, ZH, bh >> 3, bh & 7, qb, tid);
#endif
 }
                else { const int r = it - 2112; const int gg = r & 3, sp = (r >> 2) & 15, bb = r >> 6;
#ifndef NO_GMLP
gmlp_item(lds, ZH, gnorm, gws + (size_t)gg * 128 * 128, gbs + gg * 128, bb, sp, gg, tid);
#endif
 }
            }
        } else if (k == 7) {

#ifndef NO_XATTN
for (int it = bx; it < 1024; it += G) xattn_item(lds, QB, KVb, OB, it >> 6, (it >> 4) & 3, it & 15, tid);
#endif

        } else if (k == 5) {
            norm_rows(l == 0 ? x_in : xout, xout, Y_A, gl + 1 * D, gl + 2 * D, H2A, D, MTOK, gw, NGW, lane);
            norm_rows(mem, nullptr, nullptr, nullptr, gl + 4 * D, MEMN, D, MEMR, gw, NGW, lane);
        } else if (k == 9) {
            norm_rows(xout, xout, MRG, gl + 3 * D, gl + 5 * D, H2B, D, MTOK, gw, NGW, lane);
        } else {
            if (l + 1 < DEPTH) {
                norm_rows(xout, xout, MRG, gl + 6 * D, norms + (size_t)(l + 1) * 7 * D, ZH + HCOL, LDZ, MTOK, gw, NGW, lane);
                const int n = l + 1;
                LayerW L{a.in[3] + (size_t)n * D * DIN, a.in[4] + (size_t)n * DIN, a.in[10] + (size_t)n * 3 * 512 * 1024, a.in[11] + (size_t)n * D * D, a.in[12] + (size_t)n * D * D,
                         a.in[13] + (size_t)n * D * 2 * D, a.in[14] + (size_t)n * D * D, a.in[15] + (size_t)n * D * DFF, a.in[16] + (size_t)n * DFF * D};
                convert_weights(L, ws, lds, gw, NGW, wave, lane, gtid, NGT);
            } else {
                norm_rows(xout, xout, MRG, gl + 6 * D, nullptr, nullptr, 0, MTOK, gw, NGW, lane);
            }
        }
    }
    }
}

extern "C" void kernel_launch(void* const* d_in, const int* in_sizes, int n_in, void* d_out, int out_size, void* d_ws, size_t ws_size, hipStream_t stream) {
    static int grid = 0;
    if (grid == 0) {
        if (n_in != 17 || ws_size < WS_END) { fprintf(stderr, "kernel_launch: unexpected n_in %d or ws_size %zu (< %zu)\n", n_in, ws_size, (size_t)WS_END); grid = -1; return; }
        int dev = 0, cus = 0, per_cu = 0;
        (void)hipGetDevice(&dev);
        (void)hipDeviceGetAttribute(&cus, hipDeviceAttributeMultiprocessorCount, dev);
        if (hipFuncSetAttribute((const void*)fwd_kernel, hipFuncAttributeMaxDynamicSharedMemorySize, LDS_BYTES) != hipSuccess) { fprintf(stderr, "kernel_launch: hipFuncSetAttribute failed\n"); }
        if (hipOccupancyMaxActiveBlocksPerMultiprocessor(&per_cu, (const void*)fwd_kernel, 512, LDS_BYTES) != hipSuccess || per_cu < 1) { fprintf(stderr, "kernel_launch: occupancy query says %d\n", per_cu); per_cu = 1; }
        (void)hipGetLastError();
        if (cus <= 0) cus = 256;
        if (cus < 256) fprintf(stderr, "kernel_launch: device reports %d CUs; this kernel is built for a 256-workgroup cooperative grid\n", cus);
        grid = 256;
    }
    if (grid < 0) return;
    (void)hipMemsetAsync((char*)d_ws + WS_CTL, 0, 4096, stream);
    Args a{};
    for (int i = 0; i < 17; ++i) a.in[i] = (const float*)d_in[i];
    a.out = (float*)d_out; a.ws = (unsigned char*)d_ws;
#if MK_MULTI
    for (int ph = 0; ph < NPHASE; ++ph) {
        a.ph_lo = ph; a.ph_hi = ph + 1;
        hipLaunchKernelGGL(fwd_kernel, dim3(grid), dim3(512), LDS_BYTES, stream, a);
    }
#else
    a.ph_lo = 0; a.ph_hi = NPHASE;
    void* args[] = {&a};
    hipError_t e = hipLaunchCooperativeKernel((const void*)fwd_kernel, dim3(grid), dim3(512), args, LDS_BYTES, stream);
    if (e != hipSuccess) fprintf(stderr, "cooperative launch failed: %s (grid %d)\n", hipGetErrorString(e), grid);
#endif
}
```

```cpp
#include <hip/hip_runtime.h>
#include <hip/hip_cooperative_groups.h>
#include <cstdio>
#include <cstdint>
namespace cg = cooperative_groups;

#ifndef MK_MULTI
#define MK_MULTI 0
#endif

#define LAS __attribute__((address_space(3)))
typedef unsigned short bf16_t;
typedef short bf16x8 __attribute__((ext_vector_type(8)));
typedef float f32x4 __attribute__((ext_vector_type(4)));
typedef unsigned u32x4 __attribute__((ext_vector_type(4)));
typedef unsigned u32x2 __attribute__((ext_vector_type(2)));
typedef float f32x2_t __attribute__((ext_vector_type(2)));
typedef __bf16 bf16x2_t __attribute__((ext_vector_type(2)));

namespace pg8 {
#define PG8_LAS __attribute__((address_space(3)))
constexpr int BM = 256, BK = 64, HALF = 128, HTB = HALF * BK * 2, STAGE_BYTES = 8 * HTB, NXCD = 8, WGM = 8;

__host__ __device__ __forceinline__ int lds_byte(int r, int c) { const int st = (r >> 4) * 2 + (c >> 5), rr = r & 15, cc = c & 31, ob = rr * 64 + cc * 2; return st * 1024 + (ob ^ (((ob >> 9) & 1) << 5)); }
__host__ __device__ __forceinline__ void stage_rc(int b, int& R, int& C) { const int st = b / 1024, sb = b % 1024, swz = sb ^ (((sb >> 9) & 1) << 5); R = (st >> 1) * 16 + swz / 64; C = (st & 1) * 32 + (swz % 64) / 2; }
__host__ __device__ __forceinline__ int perm32(int rho) { const int n = rho >> 4, i = rho & 15; return 8 * (i >> 2) + 4 * n + (i & 3); }

struct Unit { int pm, pn, sub; long aoff, boff; };
struct Gemm { const bf16_t* A; const bf16_t* Bt; int lda, K; };

template <class Epi, class Sched, bool ALIGN_EPI>
__device__ __forceinline__ void gemm_phase(PG8_LAS unsigned char* lds, const Gemm g, const Sched& S, const Epi& E, int tid) {
    asm volatile("" : "+v"(tid));
    const int wid = __builtin_amdgcn_readfirstlane(tid >> 6), lane = tid & 63, wr = wid >> 2, wc = wid & 3, fr = lane & 15, fq = lane >> 4;
    const int K = g.K, nt = K / BK, lda = g.lda;
    unsigned voffA[2], voffB[2];
#pragma unroll
    for (int i = 0; i < 2; ++i) { int R, C; stage_rc(tid * 16 + i * 8192, R, C); const int Rb = Epi::PERM ? ((R & ~31) + perm32(R & 31)) : R;
        voffA[i] = (unsigned)(R * lda + C) * 2u; voffB[i] = (unsigned)(Rb * K + C) * 2u; }
    const size_t kstep = (size_t)(BK * 2);
    const size_t hstepA = (size_t)HALF * lda * 2, hstepB = (size_t)HALF * K * 2;
    const unsigned ldsw = (unsigned)wid * 1024u;
    const int aoff = lds_byte(wr * 64 + fr, fq * 8), boff = lds_byte(wc * 32 + fr, fq * 8);
#define PG8_SA(b, h) (((b) * 2 + (h)) * HTB)
#define PG8_SB(b, h) ((4 + (b) * 2 + (h)) * HTB)
#define PG8_STAGE(bufoff, gbase, voff) do { _Pragma("unroll") for (int _i = 0; _i < 2; ++_i) \
        __builtin_amdgcn_global_load_lds((const unsigned*)((const char*)(gbase) + (voff)[_i]), (PG8_LAS unsigned*)(lds + (bufoff) + ldsw + _i * 8192), 16, 0, 0); } while (0)
#define PG8_LDA(dst, b, h) do { _Pragma("unroll") for (int m = 0; m < 4; ++m) _Pragma("unroll") for (int k = 0; k < 2; ++k) dst[m][k] = *(const PG8_LAS bf16x8*)(lds + PG8_SA(b, h) + aoff + m * 2048 + k * 1024); } while (0)
#define PG8_LDB(dst, b, h) do { _Pragma("unroll") for (int n = 0; n < 2; ++n) _Pragma("unroll") for (int k = 0; k < 2; ++k) dst[n][k] = *(const PG8_LAS bf16x8*)(lds + PG8_SB(b, h) + boff + n * 2048 + k * 1024); } while (0)
#define PG8_MMA(ai, bj, At, Bt) do { __builtin_amdgcn_s_setprio(1); _Pragma("unroll") for (int m = 0; m < 4; ++m) _Pragma("unroll") for (int n = 0; n < 2; ++n) _Pragma("unroll") for (int k = 0; k < 2; ++k) \
        acc[ai][bj][m][n] = __builtin_amdgcn_mfma_f32_16x16x32_bf16(Bt[n][k], At[m][k], acc[ai][bj][m][n], 0, 0, 0); __builtin_amdgcn_s_setprio(0); } while (0)
#define PG8_WAIT_V(n) asm volatile("s_waitcnt vmcnt(" #n ")" ::: "memory")
#define PG8_WAIT_L(n) asm volatile("s_waitcnt lgkmcnt(" #n ")" ::: "memory")
#define PG8_BAR __builtin_amdgcn_s_barrier()
#define PG8_SCHED __builtin_amdgcn_sched_barrier(0)
    Unit cur, nxt; int ui = 0;
    if (!S.next(0, cur)) return;
    f32x4 acc[2][2][4][2];
#pragma unroll
    for (int a = 0; a < 2; ++a)
#pragma unroll
        for (int b = 0; b < 2; ++b)
#pragma unroll
            for (int m = 0; m < 4; ++m)
#pragma unroll
                for (int n = 0; n < 2; ++n) acc[a][b][m][n] = (f32x4){0.f, 0.f, 0.f, 0.f};
    bf16x8 At[4][2], B0[2][2], B1[2][2];
    const char* cA = (const char*)g.A + cur.aoff * 2; const char* cB = (const char*)g.Bt + cur.boff * 2;
    PG8_STAGE(PG8_SB(0, 0), cB, voffB); PG8_STAGE(PG8_SB(0, 1), cB + hstepB, voffB); PG8_STAGE(PG8_SA(0, 0), cA, voffA); PG8_STAGE(PG8_SA(0, 1), cA + hstepA, voffA);
    if (wr == 1) PG8_BAR;
    PG8_WAIT_V(2); PG8_BAR;
    PG8_STAGE(PG8_SB(1, 0), cB + kstep, voffB); PG8_STAGE(PG8_SA(1, 0), cA + kstep, voffA); PG8_STAGE(PG8_SB(1, 1), cB + hstepB + kstep, voffB);
    PG8_WAIT_V(6); PG8_BAR;
    for (;;) {
        const bool has_next = S.next(ui + 1, nxt);
        const char* nA = has_next ? (const char*)g.A + nxt.aoff * 2 : cA; const char* nB = has_next ? (const char*)g.Bt + nxt.boff * 2 : cB;
        for (int t = 0; t < nt; t += 2) {
            const bool last = (t == nt - 2);
            const char* a1 = cA + (size_t)(t + 1) * kstep;
            const char* a2 = last ? nA : cA + (size_t)(t + 2) * kstep; const char* b2 = last ? nB : cB + (size_t)(t + 2) * kstep;
            const char* a3 = a2 + kstep; const char* b3 = b2 + kstep;
            PG8_LDB(B0, 0, 0); PG8_LDB(B1, 0, 1); PG8_SCHED; PG8_LDA(At, 0, 0); PG8_STAGE(PG8_SA(1, 1), a1 + hstepA, voffA);
            PG8_WAIT_V(8); PG8_WAIT_L(0); PG8_BAR; PG8_MMA(0, 0, At, B0); PG8_MMA(0, 1, At, B1); PG8_BAR; PG8_SCHED;
            PG8_LDA(At, 0, 1); PG8_STAGE(PG8_SB(0, 0), b2, voffB); PG8_STAGE(PG8_SB(0, 1), b2 + hstepB, voffB); PG8_STAGE(PG8_SA(0, 0), a2, voffA);
            PG8_WAIT_V(8); PG8_WAIT_L(0); PG8_BAR; PG8_MMA(1, 0, At, B0); PG8_MMA(1, 1, At, B1); PG8_BAR; PG8_SCHED;
            PG8_LDB(B0, 1, 0); PG8_LDB(B1, 1, 1); PG8_SCHED; PG8_LDA(At, 1, 0); PG8_STAGE(PG8_SA(0, 1), a2 + hstepA, voffA);
            PG8_WAIT_V(8); PG8_WAIT_L(0); PG8_BAR; PG8_MMA(0, 0, At, B0); PG8_MMA(0, 1, At, B1); PG8_BAR; PG8_SCHED;
            PG8_LDA(At, 1, 1); PG8_STAGE(PG8_SB(1, 0), b3, voffB); PG8_STAGE(PG8_SB(1, 1), b3 + hstepB, voffB); PG8_STAGE(PG8_SA(1, 0), a3, voffA);
            PG8_WAIT_V(8); PG8_WAIT_L(0); PG8_BAR; PG8_MMA(1, 0, At, B0); PG8_MMA(1, 1, At, B1); PG8_BAR; PG8_SCHED;
        }
        if constexpr (ALIGN_EPI) { if (wr == 0) PG8_BAR; }
        E(acc, cur, wr, wc, fr, fq);
        if (!has_next) break;
#pragma unroll
        for (int a = 0; a < 2; ++a)
#pragma unroll
            for (int b = 0; b < 2; ++b)
#pragma unroll
                for (int m = 0; m < 4; ++m)
#pragma unroll
                    for (int n = 0; n < 2; ++n) acc[a][b][m][n] = (f32x4){0.f, 0.f, 0.f, 0.f};
        cur = nxt; cA = nA; cB = nB; ++ui;
        if constexpr (ALIGN_EPI) { if (wr == 1) PG8_BAR; }
    }
    PG8_WAIT_V(0);
    if constexpr (!ALIGN_EPI) { if (wr == 0) PG8_BAR; }
    PG8_BAR;
#undef PG8_SA
#undef PG8_SB
#undef PG8_STAGE
#undef PG8_LDA
#undef PG8_LDB
#undef PG8_MMA
#undef PG8_WAIT_V
#undef PG8_WAIT_L
#undef PG8_BAR
#undef PG8_SCHED
}
}

constexpr int D = 1024, BATCH = 16, SEQ = 2048, MTOK = BATCH * SEQ, DEPTH = 2, MEMR = 16 * 256, DFF = 4096, DIN = 7696;
constexpr int LDZ = 5888, HCOL = 4864;
constexpr int ZC_FQ = 0, ZC_FK = 512, ZC_FV = 1024, ZC_MQ = 1536, ZC_MK = 2048, ZC_MV = 2560, ZC_MO = 3072, ZC_GU = 3584, ZC_GV = 4096, ZC_SM = 4608;
constexpr int ZC_SCR = 1024;
constexpr float EPS = 1e-6f;
constexpr int NPHASE = 25;
constexpr int LDS_BYTES = 147456;

constexpr size_t MiB = 1u << 20;
constexpr size_t WS_CTL = 0;
constexpr size_t WS_WIN = 1 * MiB;
constexpr size_t WS_WM = WS_WIN + (size_t)4864 * 1024 * 2;
constexpr size_t WS_WO = WS_WM + (size_t)6144 * 1024 * 2;
constexpr size_t WS_WXQ = WS_WO + 2 * MiB;
constexpr size_t WS_WXKV = WS_WXQ + 2 * MiB;
constexpr size_t WS_WXO = WS_WXKV + 4 * MiB;
constexpr size_t WS_W1 = WS_WXO + 2 * MiB;
constexpr size_t WS_W2 = WS_W1 + 8 * MiB;
constexpr size_t WS_BIASZ = WS_W2 + 8 * MiB;
constexpr size_t WS_KV = 50 * MiB;
constexpr size_t WS_MEMN = 66 * MiB;
constexpr size_t WS_ZH = 74 * MiB;
constexpr size_t WS_MRG = 442 * MiB;
constexpr size_t WS_END = 506 * MiB;
static_assert(WS_BIASZ + 4864 * 4 <= WS_KV, "ws map");

__device__ __forceinline__ float bf_lo(unsigned u) { return __uint_as_float(u << 16); }
__device__ __forceinline__ float bf_hi(unsigned u) { return __uint_as_float(u & 0xffff0000u); }
__device__ __forceinline__ float bf2f(bf16_t b) { return __uint_as_float(((unsigned)b) << 16); }
__device__ __forceinline__ unsigned pk2(float lo, float hi) { f32x2_t v = {lo, hi}; bf16x2_t b = __builtin_convertvector(v, bf16x2_t); return __builtin_bit_cast(unsigned, b); }
__device__ __forceinline__ bf16_t f2bf(float f) { return (bf16_t)(pk2(f, 0.f) & 0xffffu); }
__device__ __forceinline__ float wave_sum(float v) {
#pragma unroll
    for (int o = 1; o < 64; o <<= 1) v += __shfl_xor(v, o);
    return v;
}
__device__ __forceinline__ float sigmoidf_(float x) { return 1.f / (1.f + __expf(-x)); }
__device__ __forceinline__ float logsigmoidf_(float x) { return fminf(x, 0.f) - log1pf(__expf(-fabsf(x))); }
__device__ __forceinline__ float gelu_tanh(float x) { const float u = 0.7978845608028654f * (x + 0.044715f * x * x * x); const float t = 1.f - 2.f / (__expf(2.f * u) + 1.f); return 0.5f * x * (1.f + t); }
#define MFMA16(a, b, c) __builtin_amdgcn_mfma_f32_16x16x32_bf16((a), (b), (c), 0, 0, 0)
__device__ __forceinline__ bf16x8 frag(const LAS bf16_t* p, int ld, int row0, int k0, int lane) { return *(const LAS bf16x8*)(p + (row0 + (lane & 15)) * ld + k0 + (lane >> 4) * 8); }
#define LDS_FENCE() asm volatile("s_waitcnt lgkmcnt(0)" ::: "memory")

__device__ __forceinline__ void tile_map(int wgid, int nM, int nN, int& pm, int& pn) {
    const int nwg = nM * nN;
    { const int q = nwg / pg8::NXCD, r = nwg % pg8::NXCD, xcd = wgid % pg8::NXCD, off = wgid / pg8::NXCD; wgid = (xcd < r ? xcd * (q + 1) : r * (q + 1) + (xcd - r) * q) + off; }
    const int nig = pg8::WGM * nN, gid = wgid / nig, fm = gid * pg8::WGM, gsz = (nM - fm) < pg8::WGM ? (nM - fm) : pg8::WGM;
    pm = fm + ((wgid % nig) % gsz); pn = (wgid % nig) / gsz;
}
struct USched {
    int mode;
    int G, c, nM0, nN0, nM1, nN1;
    long lda, K, a0col, a1off, b1off;
    __device__ __forceinline__ bool next(int i, pg8::Unit& u) const {
        if (mode == 2) {
            const int ti = i / 6, s = i - ti * 6; const long L = (long)ti * G + c; if (L >= (long)nM0 * nN0) return false;
            int pm, pn; tile_map((int)L, nM0, nN0, pm, pn);
            const int n = s >> 1, br = s & 1;
            const long acol = br ? (n == 0 ? (long)ZC_FQ : (n == 1 ? (long)ZC_MO : (long)ZC_GU)) : (long)HCOL;
            u.pm = pm; u.pn = pn; u.sub = s; u.aoff = (long)pm * 256 * lda + acol; u.boff = ((long)(br ? 3072 : 0) + n * 1024 + pn * 256) * K; return true;
        }
        const long L = (long)i * G + c; const long n0 = (long)nM0 * nN0;
        if (L < n0) { int pm, pn; tile_map((int)L, nM0, nN0, pm, pn); u.pm = pm; u.pn = pn; u.sub = 0; u.aoff = (long)pm * 256 * lda + a0col; u.boff = (long)pn * 256 * K; return true; }
        if (mode == 1 && L < n0 + (long)nM1 * nN1) { int pm, pn; tile_map((int)(L - n0), nM1, nN1, pm, pn); u.pm = pm; u.pn = pn; u.sub = 1; u.aoff = a1off + (long)pm * 256 * lda; u.boff = b1off + (long)pn * 256 * K; return true; }
        return false;
    }
};

struct EpiStore {
    static constexpr bool PERM = true;
    bf16_t* O0; bf16_t* O1; int ldc0, ldc1, act; const float* bias;
    __device__ __forceinline__ void operator()(const f32x4 (&acc)[2][2][4][2], const pg8::Unit& u, int wr, int wc, int fr, int fq) const {
        bf16_t* base = u.sub ? O1 : O0; const int ldc = u.sub ? ldc1 : ldc0;
        const int row0 = u.pm * 256 + wr * 64 + fr, col0 = u.pn * 256 + wc * 32 + 8 * fq;
        f32x4 bv[2][2];
#pragma unroll
        for (int bj = 0; bj < 2; ++bj)
#pragma unroll
            for (int n = 0; n < 2; ++n) bv[bj][n] = bias ? *(const f32x4*)(bias + col0 + bj * 128 + 4 * n) : (f32x4){0.f, 0.f, 0.f, 0.f};
#pragma unroll
        for (int ai = 0; ai < 2; ++ai)
#pragma unroll
            for (int m = 0; m < 4; ++m) { bf16_t* rowp = base + (size_t)(row0 + ai * 128 + m * 16) * ldc + col0;
#pragma unroll
                for (int bj = 0; bj < 2; ++bj) { f32x4 v0 = acc[ai][bj][m][0] + bv[bj][0], v1 = acc[ai][bj][m][1] + bv[bj][1];
                    if (act == 2) {
#pragma unroll
                        for (int e = 0; e < 4; ++e) { const float a0 = fmaxf(v0[e], 0.f), a1 = fmaxf(v1[e], 0.f); v0[e] = a0 * a0; v1[e] = a1 * a1; } }
                    u32x4 w; w.x = pk2(v0[0], v0[1]); w.y = pk2(v0[2], v0[3]); w.z = pk2(v1[0], v1[1]); w.w = pk2(v1[2], v1[3]);
                    *(u32x4*)(rowp + bj * 128) = w; } }
    }
};
struct EpiMerge {
    static constexpr bool PERM = true;
    bf16_t* Z; bf16_t* MRG; const float* gbias;
    __device__ __forceinline__ void operator()(const f32x4 (&acc)[2][2][4][2], const pg8::Unit& u, int wr, int wc, int fr, int fq) const {
        const int n = u.sub >> 1, br = u.sub & 1;
        const int row0 = u.pm * 256 + wr * 64 + fr, col0 = u.pn * 256 + wc * 32 + 8 * fq;
#pragma unroll
        for (int ai = 0; ai < 2; ++ai)
#pragma unroll
            for (int m = 0; m < 4; ++m) { const size_t row = (size_t)(row0 + ai * 128 + m * 16);
                bf16_t* sp = Z + row * LDZ + ZC_SCR + col0; bf16_t* mp = MRG + row * D + col0;
#pragma unroll
                for (int bj = 0; bj < 2; ++bj) { f32x4 v0 = acc[ai][bj][m][0], v1 = acc[ai][bj][m][1];
                    if (!br) {
                        const f32x4 b0 = *(const f32x4*)(gbias + n * 1024 + col0 + bj * 128), b1 = *(const f32x4*)(gbias + n * 1024 + col0 + bj * 128 + 4);
#pragma unroll
                        for (int e = 0; e < 4; ++e) { v0[e] = sigmoidf_(v0[e] + b0[e]); v1[e] = sigmoidf_(v1[e] + b1[e]); }
                        u32x4 w; w.x = pk2(v0[0], v0[1]); w.y = pk2(v0[2], v0[3]); w.z = pk2(v1[0], v1[1]); w.w = pk2(v1[2], v1[3]);
                        *(u32x4*)(sp + bj * 128) = w;
                    } else {
                        const u32x4 s = *(const u32x4*)(sp + bj * 128);
                        v0[0] *= bf_lo(s.x); v0[1] *= bf_hi(s.x); v0[2] *= bf_lo(s.y); v0[3] *= bf_hi(s.y);
                        v1[0] *= bf_lo(s.z); v1[1] *= bf_hi(s.z); v1[2] *= bf_lo(s.w); v1[3] *= bf_hi(s.w);
                        if (n > 0) { const u32x4 q = *(const u32x4*)(mp + bj * 128);
                            v0[0] += bf_lo(q.x); v0[1] += bf_hi(q.x); v0[2] += bf_lo(q.y); v0[3] += bf_hi(q.y);
                            v1[0] += bf_lo(q.z); v1[1] += bf_hi(q.z); v1[2] += bf_lo(q.w); v1[3] += bf_hi(q.w); }
                        u32x4 w; w.x = pk2(v0[0], v0[1]); w.y = pk2(v0[2], v0[3]); w.z = pk2(v1[0], v1[1]); w.w = pk2(v1[2], v1[3]);
                        *(u32x4*)(mp + bj * 128) = w;
                    } } }
    }
};

__device__ __forceinline__ void norm_rows(const float* xsrc, float* xdst, const bf16_t* y, const float* gpost, const float* gpre, bf16_t* hout, int ldh, int nrows, int gw, int NGW, int lane) {
#pragma unroll 1
    for (int m = gw; m < nrows; m += NGW) {
        f32x4 v[4];
        const f32x4* xr = (const f32x4*)(xsrc + (size_t)m * D) + lane;
#pragma unroll
        for (int j = 0; j < 4; ++j) v[j] = xr[64 * j];
        if (y) {
            const u32x2* yr = (const u32x2*)(y + (size_t)m * D) + lane;
            f32x4 yv[4]; float ss = 0.f;
#pragma unroll
            for (int j = 0; j < 4; ++j) { const u32x2 t = yr[64 * j]; yv[j] = (f32x4){bf_lo(t.x), bf_hi(t.x), bf_lo(t.y), bf_hi(t.y)};
                ss += (yv[j][0] * yv[j][0] + yv[j][1] * yv[j][1]) + (yv[j][2] * yv[j][2] + yv[j][3] * yv[j][3]); }
            ss = wave_sum(ss); const float r = 1.f / sqrtf(ss * (1.f / D) + EPS);
            f32x4* xo = (f32x4*)(xdst + (size_t)m * D) + lane;
#pragma unroll
            for (int j = 0; j < 4; ++j) { const f32x4 gp = ((const f32x4*)gpost)[lane + 64 * j]; v[j] = v[j] + yv[j] * r * gp; xo[64 * j] = v[j]; }
        }
        if (hout) {
            float ss = 0.f;
#pragma unroll
            for (int j = 0; j < 4; ++j) ss += (v[j][0] * v[j][0] + v[j][1] * v[j][1]) + (v[j][2] * v[j][2] + v[j][3] * v[j][3]);
            ss = wave_sum(ss); const float r = 1.f / sqrtf(ss * (1.f / D) + EPS);
            u32x2* ho = (u32x2*)(hout + (size_t)m * ldh) + lane;
#pragma unroll
            for (int j = 0; j < 4; ++j) { const f32x4 gp = ((const f32x4*)gpre)[lane + 64 * j]; const f32x4 o = v[j] * r * gp; u32x2 w; w.x = pk2(o[0], o[1]); w.y = pk2(o[2], o[3]); ho[64 * j] = w; }
        }
    }
}

__device__ __forceinline__ void tr_item(const float* W, int ldw, int col0, bf16_t* WT, int ldt, int row0, int nblk, LAS float* scr, int item, int lane) {
    const int kb = item / nblk, nb = item % nblk, k0 = 64 * kb, n0 = 32 * nb;
#pragma unroll 8
    for (int i = 0; i < 32; ++i) { const int kk = 2 * i + (lane >> 5); scr[kk * 33 + (lane & 31)] = W[(size_t)(k0 + kk) * ldw + col0 + n0 + (lane & 31)]; }
    LDS_FENCE();
    const int c = lane & 7;
#pragma unroll
    for (int j = 0; j < 4; ++j) { const int n = (lane >> 3) + 8 * j; const LAS float* s = scr + (8 * c) * 33 + n;
        u32x4 o; o.x = pk2(s[0 * 33], s[1 * 33]); o.y = pk2(s[2 * 33], s[3 * 33]); o.z = pk2(s[4 * 33], s[5 * 33]); o.w = pk2(s[6 * 33], s[7 * 33]);
        *(u32x4*)(WT + (size_t)(row0 + n0 + n) * ldt + k0 + 8 * c) = o; }
    LDS_FENCE();
}
__device__ __forceinline__ int small_src(int i) { return i < 8 ? 1536 + i : (i < 12 ? 3080 + (i - 8) : 3084 + (i - 12)); }
struct LayerW { const float *w_in, *b_in, *w_branch, *w_out, *w_xq, *w_xkv, *w_xo, *w_ff1, *w_ff2; };
__device__ __forceinline__ void convert_weights(const LayerW& L, unsigned char* ws, LAS unsigned char* lds, int gw, int NGW, int wave, int lane, int gtid, int NGT) {
    bf16_t* Win_t = (bf16_t*)(ws + WS_WIN); bf16_t* Wm_t = (bf16_t*)(ws + WS_WM); bf16_t* Wo_t = (bf16_t*)(ws + WS_WO); bf16_t* Wxq_t = (bf16_t*)(ws + WS_WXQ);
    bf16_t* Wxkv_t = (bf16_t*)(ws + WS_WXKV); bf16_t* Wxo_t = (bf16_t*)(ws + WS_WXO); bf16_t* W1_t = (bf16_t*)(ws + WS_W1); bf16_t* W2_t = (bf16_t*)(ws + WS_W2);
    float* biasz = (float*)(ws + WS_BIASZ);
    LAS float* scr = (LAS float*)(lds + wave * 16384);
    constexpr int NIT = 768 + 768 + 256 + 512 + 1536 + 3 * 256 + 512 + 512 + 1024 + 512 + 2048 + 2048;
#pragma unroll 1
    for (int it = gw; it < NIT; it += NGW) {
        int r = it;
        if (r < 768) { tr_item(L.w_in, DIN, 0, Win_t, 1024, 0, 48, scr, r, lane); continue; } r -= 768;
        if (r < 768) { tr_item(L.w_in, DIN, 1544, Win_t, 1024, 1536, 48, scr, r, lane); continue; } r -= 768;
        if (r < 256) { tr_item(L.w_in, DIN, 3088, Win_t, 1024, 3072, 16, scr, r, lane); continue; } r -= 256;
        if (r < 512) { tr_item(L.w_in, DIN, 3600, Win_t, 1024, 3584, 32, scr, r, lane); continue; } r -= 512;
        if (r < 1536) { tr_item(L.w_in, DIN, 4624, Wm_t, 1024, 0, 96, scr, r, lane); continue; } r -= 1536;
        if (r < 768) { const int n = r >> 8; tr_item(L.w_branch + (size_t)n * 512 * 1024, 1024, 0, Wm_t, 1024, 3072 + n * 1024, 32, scr, r & 255, lane); continue; } r -= 768;
        if (r < 512) { tr_item(L.w_out, 1024, 0, Wo_t, 1024, 0, 32, scr, r, lane); continue; } r -= 512;
        if (r < 512) { tr_item(L.w_xq, 1024, 0, Wxq_t, 1024, 0, 32, scr, r, lane); continue; } r -= 512;
        if (r < 1024) { tr_item(L.w_xkv, 2048, 0, Wxkv_t, 1024, 0, 64, scr, r, lane); continue; } r -= 1024;
        if (r < 512) { tr_item(L.w_xo, 1024, 0, Wxo_t, 1024, 0, 32, scr, r, lane); continue; } r -= 512;
        if (r < 2048) { tr_item(L.w_ff1, 4096, 0, W1_t, 1024, 0, 128, scr, r, lane); continue; } r -= 2048;
        tr_item(L.w_ff2, 1024, 0, W2_t, 4096, 0, 32, scr, r, lane);
    }
    const u32x4 z4 = {0u, 0u, 0u, 0u};
#pragma unroll 1
    for (int i = gtid; i < 3072 * 64; i += NGT) { const int row = i >> 6, c = i & 63; *(u32x4*)(Wm_t + (size_t)(3072 + row) * 1024 + 512 + c * 8) = z4; }
#pragma unroll 1
    for (int i = gtid; i < 240 * 128; i += NGT) { const int row = i >> 7, c = i & 127; *(u32x4*)(Win_t + (size_t)(4624 + row) * 1024 + c * 8) = z4; }
#pragma unroll 1
    for (int i = gtid; i < 16 * 1024; i += NGT) { const int j = i >> 10, k = i & 1023; Win_t[(size_t)(4608 + j) * 1024 + k] = f2bf(L.w_in[(size_t)k * DIN + small_src(j)]); }
#pragma unroll 1
    for (int c = gtid; c < 4864; c += NGT) {
        float v;
        if (c < 1536) v = L.b_in[c]; else if (c < 3072) v = L.b_in[1544 + c - 1536]; else if (c < 3584) v = L.b_in[3088 + c - 3072];
        else if (c < 4608) v = L.b_in[3600 + c - 3584]; else if (c < 4624) v = L.b_in[small_src(c - 4608)]; else v = 0.f;
        biasz[c] = v;
    }
}

__device__ __forceinline__ void fox_item(LAS unsigned char* lds, bf16_t* Z, int b, int h, int qb, int tid) {
    asm volatile("" : "+v"(tid));
    const int lane = tid & 63, w = __builtin_amdgcn_readfirstlane(tid >> 6), fr = lane & 15, fq = lane >> 4;
    LAS float* Fs = (LAS float*)lds;
    LAS float* wsum = (LAS float*)(lds + 8192);
    LAS bf16_t* Ks = (LAS bf16_t*)(lds + 8448);
    LAS bf16_t* Vt = Ks + 64 * 72;
    LAS bf16_t* Ps = Vt + 64 * 72 + w * 16 * 72;
    const int q0 = qb * 128, q1 = q0 + 128;
    const size_t rowbase = (size_t)b * SEQ;
    {
        float lf[4]; float run = 0.f;
#pragma unroll
        for (int i = 0; i < 4; ++i) { const int t = 4 * tid + i; float v = 0.f; if (t < q1) v = logsigmoidf_(bf2f(Z[(rowbase + t) * LDZ + ZC_SM + h])); run += v; lf[i] = run; }
        float sc = run;
#pragma unroll
        for (int o = 1; o < 64; o <<= 1) { const float nb = __shfl_up(sc, o); if (lane >= o) sc += nb; }
        if (lane == 63) wsum[w] = sc;
        __syncthreads();
        float base = 0.f;
        for (int i = 0; i < w; ++i) base += wsum[i];
        const float excl = base + sc - run;
#pragma unroll
        for (int i = 0; i < 4; ++i) Fs[4 * tid + i] = excl + lf[i];
        __syncthreads();
    }
    const int qrow = q0 + w * 16;
    bf16x8 qf[2];
#pragma unroll
    for (int ks = 0; ks < 2; ++ks) qf[ks] = *(const bf16x8*)(Z + (rowbase + qrow + fr) * LDZ + ZC_FQ + h * 64 + ks * 32 + fq * 8);
    float Ft[4], mrow[4], lrow[4];
#pragma unroll
    for (int j = 0; j < 4; ++j) { Ft[j] = Fs[qrow + fq * 4 + j]; mrow[j] = -INFINITY; lrow[j] = 0.f; }
    f32x4 O[4];
#pragma unroll
    for (int nt = 0; nt < 4; ++nt) O[nt] = (f32x4){0.f, 0.f, 0.f, 0.f};
    const int nkt = q1 / 64;
    for (int kt = 0; kt < nkt; ++kt) {
        __syncthreads();
        {   const int key = tid >> 3, dc = tid & 7;
            const bf16_t* src = Z + (rowbase + kt * 64 + key) * LDZ + h * 64 + dc * 8;
            const u32x4 kv = *(const u32x4*)(src + ZC_FK); const u32x4 vv = *(const u32x4*)(src + ZC_FV);
            *(LAS u32x4*)(Ks + key * 72 + dc * 8) = kv;
            LAS bf16_t* vp = Vt + (dc * 8) * 72 + key;
            vp[0 * 72] = (bf16_t)(vv.x & 0xffffu); vp[1 * 72] = (bf16_t)(vv.x >> 16); vp[2 * 72] = (bf16_t)(vv.y & 0xffffu); vp[3 * 72] = (bf16_t)(vv.y >> 16);
            vp[4 * 72] = (bf16_t)(vv.z & 0xffffu); vp[5 * 72] = (bf16_t)(vv.z >> 16); vp[6 * 72] = (bf16_t)(vv.w & 0xffffu); vp[7 * 72] = (bf16_t)(vv.w >> 16);
        }
        __syncthreads();
        if (kt * 64 <= qrow + 15) {
            f32x4 S[4];
#pragma unroll
            for (int nt = 0; nt < 4; ++nt) { S[nt] = (f32x4){0.f, 0.f, 0.f, 0.f};
#pragma unroll
                for (int ks = 0; ks < 2; ++ks) S[nt] = MFMA16(qf[ks], frag(Ks, 72, nt * 16, ks * 32, lane), S[nt]); }
            float mx[4] = {-INFINITY, -INFINITY, -INFINITY, -INFINITY};
#pragma unroll
            for (int nt = 0; nt < 4; ++nt) { const int key = kt * 64 + nt * 16 + fr; const float Fk = Fs[key];
#pragma unroll
                for (int j = 0; j < 4; ++j) { const int t = qrow + fq * 4 + j; float s = S[nt][j] * 0.125f + Ft[j] - Fk; if (key > t) s = -INFINITY; S[nt][j] = s; mx[j] = fmaxf(mx[j], s); } }
#pragma unroll
            for (int j = 0; j < 4; ++j) {
                float v = mx[j];
                v = fmaxf(v, __shfl_xor(v, 1)); v = fmaxf(v, __shfl_xor(v, 2)); v = fmaxf(v, __shfl_xor(v, 4)); v = fmaxf(v, __shfl_xor(v, 8));
                const float mnew = fmaxf(mrow[j], v); const float alpha = __expf(mrow[j] - mnew); mrow[j] = mnew; lrow[j] *= alpha;
#pragma unroll
                for (int nt = 0; nt < 4; ++nt) O[nt][j] *= alpha;
            }
#pragma unroll
            for (int nt = 0; nt < 4; ++nt)
#pragma unroll
                for (int j = 0; j < 4; ++j) { const float p = __expf(S[nt][j] - mrow[j]); lrow[j] += p; Ps[(fq * 4 + j) * 72 + nt * 16 + fr] = f2bf(p); }
            LDS_FENCE();
#pragma unroll
            for (int ks = 0; ks < 2; ++ks) { const bf16x8 pf = frag(Ps, 72, 0, ks * 32, lane);
#pragma unroll
                for (int nt = 0; nt < 4; ++nt) O[nt] = MFMA16(pf, frag(Vt, 72, nt * 16, ks * 32, lane), O[nt]); }
            LDS_FENCE();
        }
    }
#pragma unroll
    for (int j = 0; j < 4; ++j) { float v = lrow[j]; v += __shfl_xor(v, 1); v += __shfl_xor(v, 2); v += __shfl_xor(v, 4); v += __shfl_xor(v, 8); lrow[j] = 1.f / v; }
#pragma unroll
    for (int nt = 0; nt < 4; ++nt)
#pragma unroll
        for (int j = 0; j < 4; ++j) Z[(rowbase + qrow + fq * 4 + j) * LDZ + ZC_FQ + h * 64 + nt * 16 + fr] = f2bf(O[nt][j] * lrow[j]);
    __syncthreads();
}

__device__ __forceinline__ void mlstm_item(LAS unsigned char* lds, bf16_t* Z, const float* convw, const float* mg, int b, int h, int tid) {
    asm volatile("" : "+v"(tid));
    const int lane = tid & 63, w = __builtin_amdgcn_readfirstlane(tid >> 6), fr = lane & 15, fq = lane >> 4;
    LAS bf16_t* Qs = (LAS bf16_t*)lds;
    LAS bf16_t* Ks = Qs + 64 * 136;
    LAS bf16_t* KWt = Ks + 64 * 136;
    LAS bf16_t* Vt = KWt + 128 * 72;
    LAS bf16_t* Ct = Vt + 144 * 72;
    LAS bf16_t* Ps = Ct + 144 * 136;
    LAS float* GA = (LAS float*)(Ps + 64 * 72);
    LAS float* GM = GA + 64; LAS float* WI = GA + 128; LAS float* EN = GA + 192; LAS float* WS = GA + 256; LAS float* SC = GA + 320;
    LAS float* SSQ = GA + 336;
    LAS float* CW = GA + 464;
    const size_t rowbase = (size_t)b * SEQ;
    for (int i = tid; i < 144 * 136 / 2; i += 512) ((LAS unsigned*)Ct)[i] = 0u;
    for (int i = tid; i < 16 * 72; i += 512) Vt[128 * 72 + i] = (i < 72) ? (bf16_t)0x3F80 : (bf16_t)0;
    for (int i = tid; i < 1024; i += 512) { const int j = i >> 8, c = i & 255; CW[i] = convw[j * 1024 + (c < 128 ? h * 128 + c : 512 + h * 128 + (c - 128))]; }
    f32x4 Cacc[9];
#pragma unroll
    for (int nt = 0; nt < 9; ++nt) Cacc[nt] = (f32x4){0.f, 0.f, 0.f, 0.f};
    float mprev = 0.f;
    const int dc = tid & 15;
    for (int ch = 0; ch < SEQ / 64; ++ch) {
        const int t0 = ch * 64;
        if (w == 0) {
            const size_t row = rowbase + t0 + lane;
            const float ip = bf2f(Z[row * LDZ + ZC_SM + 8 + h]), fp = bf2f(Z[row * LDZ + ZC_SM + 12 + h]);
            float bc = logsigmoidf_(fp);
#pragma unroll
            for (int o = 1; o < 64; o <<= 1) { const float nb = __shfl_up(bc, o); if (lane >= o) bc += nb; }
            const float av = ip - bc;
            float gm = av;
#pragma unroll
            for (int o = 1; o < 64; o <<= 1) { const float nb = __shfl_up(gm, o); if (lane >= o) gm = fmaxf(gm, nb); }
            const float mm = fmaxf(mprev, gm), mt = bc + mm;
            GA[lane] = av; GM[lane] = mm; WI[lane] = __expf(mprev - mm); EN[lane] = __expf(-mt);
            const float mm63 = __shfl(mm, 63), b63 = __shfl(bc, 63);
            WS[lane] = __expf(av - mm63);
            if (lane == 0) SC[0] = __expf(mprev - mm63);
            mprev = b63 + mm63;
        }
        __syncthreads();
#pragma unroll 1
        for (int i = 0; i < 2; ++i) {
            const int t = (tid >> 4) + 32 * i; const int tg = t0 + t;
            const size_t row = rowbase + tg;
            float aq[8], ak[8];
#pragma unroll
            for (int e = 0; e < 8; ++e) { aq[e] = 0.f; ak[e] = 0.f; }
#pragma unroll
            for (int j = 0; j < 4; ++j) {
                if (tg - 3 + j >= 0) {
                    const bf16_t* src = Z + (row - 3 + j) * LDZ + h * 128 + dc * 8;
                    const u32x4 rq = *(const u32x4*)(src + ZC_MQ), rk = *(const u32x4*)(src + ZC_MK);
                    const f32x4 wq0 = *(const LAS f32x4*)(CW + j * 256 + dc * 8), wq1 = *(const LAS f32x4*)(CW + j * 256 + dc * 8 + 4);
                    const f32x4 wk0 = *(const LAS f32x4*)(CW + j * 256 + 128 + dc * 8), wk1 = *(const LAS f32x4*)(CW + j * 256 + 128 + dc * 8 + 4);
                    aq[0] += wq0[0] * bf_lo(rq.x); aq[1] += wq0[1] * bf_hi(rq.x); aq[2] += wq0[2] * bf_lo(rq.y); aq[3] += wq0[3] * bf_hi(rq.y);
                    aq[4] += wq1[0] * bf_lo(rq.z); aq[5] += wq1[1] * bf_hi(rq.z); aq[6] += wq1[2] * bf_lo(rq.w); aq[7] += wq1[3] * bf_hi(rq.w);
                    ak[0] += wk0[0] * bf_lo(rk.x); ak[1] += wk0[1] * bf_hi(rk.x); ak[2] += wk0[2] * bf_lo(rk.y); ak[3] += wk0[3] * bf_hi(rk.y);
                    ak[4] += wk1[0] * bf_lo(rk.z); ak[5] += wk1[1] * bf_hi(rk.z); ak[6] += wk1[2] * bf_lo(rk.w); ak[7] += wk1[3] * bf_hi(rk.w);
                }
            }
            const float wst = WS[t];
#pragma unroll
            for (int e = 0; e < 8; ++e) { aq[e] = aq[e] * sigmoidf_(aq[e]); ak[e] = ak[e] * sigmoidf_(ak[e]) * 0.08838834764831845f; }
            u32x4 oq, ok;
            oq.x = pk2(aq[0], aq[1]); oq.y = pk2(aq[2], aq[3]); oq.z = pk2(aq[4], aq[5]); oq.w = pk2(aq[6], aq[7]);
            ok.x = pk2(ak[0], ak[1]); ok.y = pk2(ak[2], ak[3]); ok.z = pk2(ak[4], ak[5]); ok.w = pk2(ak[6], ak[7]);
            *(LAS u32x4*)(Qs + t * 136 + dc * 8) = oq; *(LAS u32x4*)(Ks + t * 136 + dc * 8) = ok;
#pragma unroll
            for (int e = 0; e < 8; ++e) KWt[(dc * 8 + e) * 72 + t] = f2bf(ak[e] * wst);
            const u32x4 rv = *(const u32x4*)(Z + row * LDZ + ZC_MV + h * 128 + dc * 8);
            LAS bf16_t* vp = Vt + (dc * 8) * 72 + t;
            vp[0 * 72] = (bf16_t)(rv.x & 0xffffu); vp[1 * 72] = (bf16_t)(rv.x >> 16); vp[2 * 72] = (bf16_t)(rv.y & 0xffffu); vp[3 * 72] = (bf16_t)(rv.y >> 16);
            vp[4 * 72] = (bf16_t)(rv.z & 0xffffu); vp[5 * 72] = (bf16_t)(rv.z >> 16); vp[6 * 72] = (bf16_t)(rv.w & 0xffffu); vp[7 * 72] = (bf16_t)(rv.w >> 16);
        }
        __syncthreads();
        {   const int mt = w >> 1;
#pragma unroll
            for (int x = 0; x < 2; ++x) { const int nt = (w & 1) * 2 + x;
                f32x4 acc = (f32x4){0.f, 0.f, 0.f, 0.f};
#pragma unroll
                for (int ks = 0; ks < 4; ++ks) acc = MFMA16(frag(Qs, 136, mt * 16, ks * 32, lane), frag(Ks, 136, nt * 16, ks * 32, lane), acc);
                const int s = nt * 16 + fr; const float as = GA[s];
#pragma unroll
                for (int j = 0; j < 4; ++j) { const int t = mt * 16 + fq * 4 + j; const float p = (s <= t) ? acc[j] * __expf(as - GM[t]) : 0.f; Ps[t * 72 + s] = f2bf(p); }
            }
        }
        __syncthreads();
        {   const int mt = w & 3, half = w >> 2;
            f32x4 Hacc[5];
#pragma unroll
            for (int x = 0; x < 5; ++x) { const int nt = (x < 4) ? half * 4 + x : 8;
                f32x4 acc = (f32x4){0.f, 0.f, 0.f, 0.f};
#pragma unroll
                for (int ks = 0; ks < 4; ++ks) acc = MFMA16(frag(Qs, 136, mt * 16, ks * 32, lane), frag(Ct, 136, nt * 16, ks * 32, lane), acc);
#pragma unroll
                for (int j = 0; j < 4; ++j) acc[j] *= WI[mt * 16 + fq * 4 + j];
#pragma unroll
                for (int ks = 0; ks < 2; ++ks) acc = MFMA16(frag(Ps, 72, mt * 16, ks * 32, lane), frag(Vt, 72, nt * 16, ks * 32, lane), acc);
                Hacc[x] = acc; }
            float ssq[4];
#pragma unroll
            for (int j = 0; j < 4; ++j) { const float den = __shfl(Hacc[4][j], lane & 48); const float dn = fmaxf(fabsf(den), EN[mt * 16 + fq * 4 + j]); const float inv = 1.f / dn;
                float s = 0.f;
#pragma unroll
                for (int x = 0; x < 4; ++x) { Hacc[x][j] *= inv; s += Hacc[x][j] * Hacc[x][j]; }
                s += __shfl_xor(s, 1); s += __shfl_xor(s, 2); s += __shfl_xor(s, 4); s += __shfl_xor(s, 8); ssq[j] = s; }
            if (fr == 0) {
#pragma unroll
                for (int j = 0; j < 4; ++j) SSQ[half * 64 + mt * 16 + fq * 4 + j] = ssq[j]; }
            __syncthreads();
#pragma unroll
            for (int j = 0; j < 4; ++j) { const int t = mt * 16 + fq * 4 + j; const float tot = SSQ[t] + SSQ[64 + t]; const float r = 1.f / sqrtf(tot * (1.f / 128.f) + EPS);
#pragma unroll
                for (int x = 0; x < 4; ++x) { const int e = (half * 4 + x) * 16 + fr; bf16_t* p = Z + (rowbase + t0 + t) * LDZ + ZC_MO + h * 128 + e;
                    const float hm = Hacc[x][j] * r * mg[h * 128 + e]; *p = f2bf(sigmoidf_(bf2f(*p)) * hm); } }
        }
        {   const float decay = SC[0];
#pragma unroll
            for (int nt = 0; nt < 9; ++nt) Cacc[nt] = Cacc[nt] * decay;
#pragma unroll
            for (int ks = 0; ks < 2; ++ks) { const bf16x8 af = frag(KWt, 72, w * 16, ks * 32, lane);
#pragma unroll
                for (int nt = 0; nt < 9; ++nt) Cacc[nt] = MFMA16(af, frag(Vt, 72, nt * 16, ks * 32, lane), Cacc[nt]); }
#pragma unroll
            for (int nt = 0; nt < 9; ++nt) { u32x2 o; o.x = pk2(Cacc[nt][0], Cacc[nt][1]); o.y = pk2(Cacc[nt][2], Cacc[nt][3]);
                *(LAS u32x2*)(Ct + (nt * 16 + fr) * 136 + w * 16 + fq * 4) = o; }
        }
        __syncthreads();
    }
}

__device__ __forceinline__ void gmlp_item(LAS unsigned char* lds, bf16_t* Z, const float* gnorm, const float* wsg, const float* bsg, int b, int sp, int g, int tid) {
    asm volatile("" : "+v"(tid));
    const int lane = tid & 63, w = __builtin_amdgcn_readfirstlane(tid >> 6), fr = lane & 15, fq = lane >> 4;
    LAS bf16_t* As = (LAS bf16_t*)lds;
    LAS bf16_t* Vt = As + 128 * 136;
    const size_t rowbase = (size_t)b * SEQ + sp * 128;
#pragma unroll
    for (int i = 0; i < 8; ++i) { const int idx = tid + 512 * i; const int t = idx >> 5, s4 = (idx & 31) * 4;
        f32x4 wv = *(const f32x4*)(wsg + t * 128 + s4); if ((t >> 6) < (s4 >> 6)) wv = (f32x4){0.f, 0.f, 0.f, 0.f};
        u32x2 o; o.x = pk2(wv[0], wv[1]); o.y = pk2(wv[2], wv[3]); *(LAS u32x2*)(As + t * 136 + s4) = o; }
    for (int tt = 0; tt < 16; ++tt) { const int t = w * 16 + tt;
        const u32x4 raw = *(const u32x4*)(Z + (rowbase + t) * LDZ + ZC_GV + lane * 8);
        float x[8]; x[0] = bf_lo(raw.x); x[1] = bf_hi(raw.x); x[2] = bf_lo(raw.y); x[3] = bf_hi(raw.y); x[4] = bf_lo(raw.z); x[5] = bf_hi(raw.z); x[6] = bf_lo(raw.w); x[7] = bf_hi(raw.w);
        float s = 0.f;
#pragma unroll
        for (int e = 0; e < 8; ++e) { x[e] = gelu_tanh(x[e]); s += x[e]; }
        const float mean = wave_sum(s) * (1.f / 512.f); float q = 0.f;
#pragma unroll
        for (int e = 0; e < 8; ++e) { x[e] -= mean; q += x[e] * x[e]; }
        const float rstd = 1.f / sqrtf(wave_sum(q) * (1.f / 512.f) + EPS);
        if (fq == g) {
#pragma unroll
            for (int e = 0; e < 8; ++e) Vt[(fr * 8 + e) * 136 + t] = f2bf(x[e] * rstd * gnorm[lane * 8 + e]); }
    }
    __syncthreads();
    f32x4 acc[8];
#pragma unroll
    for (int nt = 0; nt < 8; ++nt) acc[nt] = (f32x4){0.f, 0.f, 0.f, 0.f};
    const int kmax = (w < 4) ? 2 : 4;
    for (int ks = 0; ks < kmax; ++ks) { const bf16x8 af = frag(As, 136, w * 16, ks * 32, lane);
#pragma unroll
        for (int nt = 0; nt < 8; ++nt) acc[nt] = MFMA16(af, frag(Vt, 136, nt * 16, ks * 32, lane), acc[nt]); }
#pragma unroll
    for (int j = 0; j < 4; ++j) { const int t = w * 16 + fq * 4 + j; const float bt = bsg[t];
#pragma unroll
        for (int nt = 0; nt < 8; ++nt) { bf16_t* p = Z + (rowbase + t) * LDZ + ZC_GU + g * 128 + nt * 16 + fr; *p = f2bf(gelu_tanh(bf2f(*p)) * (acc[nt][j] + bt)); } }
    __syncthreads();
}

__device__ __forceinline__ void xattn_item(LAS unsigned char* lds, const bf16_t* Q, const bf16_t* KV, bf16_t* Oo, int b, int h, int qb, int tid) {
    asm volatile("" : "+v"(tid));
    const int lane = tid & 63, w = __builtin_amdgcn_readfirstlane(tid >> 6), fr = lane & 15, fq = lane >> 4;
    LAS bf16_t* Ks = (LAS bf16_t*)lds;
    LAS bf16_t* Vt = Ks + 64 * 264;
    LAS bf16_t* Ps = Vt + 256 * 72 + w * 16 * 264;
    const size_t qrow = (size_t)b * SEQ + qb * 128 + w * 16;
    bf16x8 qf[8];
#pragma unroll
    for (int ks = 0; ks < 8; ++ks) qf[ks] = *(const bf16x8*)(Q + (qrow + fr) * D + h * 256 + ks * 32 + fq * 8);
    f32x4 S[16];
#pragma unroll
    for (int kc = 0; kc < 4; ++kc) {
        __syncthreads();
#pragma unroll
        for (int i = 0; i < 4; ++i) { const int idx = tid + 512 * i; const int key = idx >> 5, dcc = idx & 31;
            *(LAS u32x4*)(Ks + key * 264 + dcc * 8) = *(const u32x4*)(KV + (size_t)(b * 256 + kc * 64 + key) * 2048 + h * 256 + dcc * 8); }
        __syncthreads();
#pragma unroll
        for (int nt = 0; nt < 4; ++nt) { f32x4 acc = (f32x4){0.f, 0.f, 0.f, 0.f};
#pragma unroll
            for (int ks = 0; ks < 8; ++ks) acc = MFMA16(qf[ks], frag(Ks, 264, nt * 16, ks * 32, lane), acc);
            S[kc * 4 + nt] = acc; }
    }
    float inv[4];
#pragma unroll
    for (int j = 0; j < 4; ++j) {
        float mx = -INFINITY;
#pragma unroll
        for (int i = 0; i < 16; ++i) mx = fmaxf(mx, S[i][j]);
        mx = fmaxf(mx, __shfl_xor(mx, 1)); mx = fmaxf(mx, __shfl_xor(mx, 2)); mx = fmaxf(mx, __shfl_xor(mx, 4)); mx = fmaxf(mx, __shfl_xor(mx, 8));
        float sum = 0.f;
#pragma unroll
        for (int i = 0; i < 16; ++i) { const float p = __expf((S[i][j] - mx) * 0.0625f); sum += p; Ps[(fq * 4 + j) * 264 + i * 16 + fr] = f2bf(p); }
        sum += __shfl_xor(sum, 1); sum += __shfl_xor(sum, 2); sum += __shfl_xor(sum, 4); sum += __shfl_xor(sum, 8);
        inv[j] = 1.f / sum;
    }
    f32x4 O[16];
#pragma unroll
    for (int nt = 0; nt < 16; ++nt) O[nt] = (f32x4){0.f, 0.f, 0.f, 0.f};
#pragma unroll
    for (int kc = 0; kc < 4; ++kc) {
        __syncthreads();
#pragma unroll
        for (int i = 0; i < 4; ++i) { const int idx = tid + 512 * i; const int key = idx >> 5, dcc = idx & 31;
            const u32x4 vv = *(const u32x4*)(KV + (size_t)(b * 256 + kc * 64 + key) * 2048 + 1024 + h * 256 + dcc * 8);
            LAS bf16_t* vp = Vt + (dcc * 8) * 72 + key;
            vp[0 * 72] = (bf16_t)(vv.x & 0xffffu); vp[1 * 72] = (bf16_t)(vv.x >> 16); vp[2 * 72] = (bf16_t)(vv.y & 0xffffu); vp[3 * 72] = (bf16_t)(vv.y >> 16);
            vp[4 * 72] = (bf16_t)(vv.z & 0xffffu); vp[5 * 72] = (bf16_t)(vv.z >> 16); vp[6 * 72] = (bf16_t)(vv.w & 0xffffu); vp[7 * 72] = (bf16_t)(vv.w >> 16); }
        __syncthreads();
#pragma unroll
        for (int ks = 0; ks < 2; ++ks) { const bf16x8 pf = frag(Ps, 264, 0, kc * 64 + ks * 32, lane);
#pragma unroll
            for (int nt = 0; nt < 16; ++nt) O[nt] = MFMA16(pf, frag(Vt, 72, nt * 16, ks * 32, lane), O[nt]); }
    }
#pragma unroll
    for (int nt = 0; nt < 16; ++nt)
#pragma unroll
        for (int j = 0; j < 4; ++j) Oo[(qrow + fq * 4 + j) * D + h * 256 + nt * 16 + fr] = f2bf(O[nt][j] * inv[j]);
    __syncthreads();
}

struct Args { const float* in[17]; float* out; unsigned char* ws; int ph_lo, ph_hi; };
__global__ void __launch_bounds__(512, 2) fwd_kernel(Args a) {
    extern __shared__ __attribute__((aligned(16))) unsigned char lds_raw[];
    LAS unsigned char* lds = (LAS unsigned char*)lds_raw;
    constexpr int G = 256; const int bx = blockIdx.x;
    cg::grid_group grid = cg::this_grid();
    for (int ph = a.ph_lo; ph < a.ph_hi; ++ph) {
    if (ph != a.ph_lo) grid.sync();
    int tid = threadIdx.x; asm volatile("" : "+v"(tid));
    unsigned char* ws = a.ws; asm volatile("" : "+s"(ws));
    const int lane = tid & 63, wave = __builtin_amdgcn_readfirstlane(tid >> 6);
    const int gw = bx * 8 + wave, NGW = G * 8, gtid = bx * 512 + tid, NGT = G * 512;
    bf16_t* ZH = (bf16_t*)(ws + WS_ZH); bf16_t* MRG = (bf16_t*)(ws + WS_MRG); bf16_t* KVb = (bf16_t*)(ws + WS_KV); bf16_t* MEMN = (bf16_t*)(ws + WS_MEMN);
    bf16_t* Y_A = ZH;
    bf16_t* H2A = (bf16_t*)(ws + WS_ZH + 64 * MiB);
    bf16_t* QB = (bf16_t*)(ws + WS_ZH + 128 * MiB);
    bf16_t* OB = (bf16_t*)(ws + WS_ZH + 192 * MiB);
    bf16_t* H2B = ZH;
    bf16_t* HID = (bf16_t*)(ws + WS_ZH + 64 * MiB);
    bf16_t* Win_t = (bf16_t*)(ws + WS_WIN); bf16_t* Wm_t = (bf16_t*)(ws + WS_WM); bf16_t* Wo_t = (bf16_t*)(ws + WS_WO); bf16_t* Wxq_t = (bf16_t*)(ws + WS_WXQ);
    bf16_t* Wxkv_t = (bf16_t*)(ws + WS_WXKV); bf16_t* Wxo_t = (bf16_t*)(ws + WS_WXO); bf16_t* W1_t = (bf16_t*)(ws + WS_W1); bf16_t* W2_t = (bf16_t*)(ws + WS_W2);
    const float* biasz = (const float*)(ws + WS_BIASZ);
    const float* x_in = a.in[0]; const float* mem = a.in[1]; const float* norms = a.in[2];
    float* xout = a.out;
    {
        if (ph == 0) {
            LayerW L{a.in[3], a.in[4], a.in[10], a.in[11], a.in[12], a.in[13], a.in[14], a.in[15], a.in[16]};
            convert_weights(L, ws, lds, gw, NGW, wave, lane, gtid, NGT);
            norm_rows(x_in, nullptr, nullptr, nullptr, norms + 0 * D, ZH + HCOL, LDZ, MTOK, gw, NGW, lane);
            continue;
        }
        const int l = (ph - 1) / 12, k = (ph - 1) % 12 + 1;
        const float* gl = norms + (size_t)l * 7 * D;
        if (k == 1 || k == 4 || k == 6 || k == 8 || k == 10 || k == 11) {
            pg8::Gemm g; USched S; EpiStore E;
            S.G = G; S.c = bx; S.mode = 0; S.nM1 = 0; S.nN1 = 0; S.a1off = 0; S.b1off = 0; S.a0col = 0; S.nM0 = 128; S.nN0 = 4;
            E.O1 = nullptr; E.ldc1 = 0; E.bias = nullptr; E.act = 0; E.ldc0 = D;
            g.lda = D; g.K = D;
            if (k == 1) { g.A = ZH; g.Bt = Win_t; g.lda = LDZ; S.nN0 = 19; S.a0col = HCOL; E.O0 = ZH; E.ldc0 = LDZ; E.bias = biasz; }
            else if (k == 4) { g.A = MRG; g.Bt = Wo_t; E.O0 = Y_A; }
            else if (k == 6) { g.A = H2A; g.Bt = Wxq_t; S.mode = 1; S.nM1 = 16; S.nN1 = 8; S.a1off = (long)(MEMN - H2A); S.b1off = (long)(Wxkv_t - Wxq_t); E.O0 = QB; E.O1 = KVb; E.ldc1 = 2048; }
            else if (k == 8) { g.A = OB; g.Bt = Wxo_t; E.O0 = MRG; }
            else if (k == 10) { g.A = H2B; g.Bt = W1_t; S.nN0 = 16; E.O0 = HID; E.ldc0 = DFF; E.act = 2; }
            else { g.A = HID; g.Bt = W2_t; g.lda = DFF; g.K = DFF; E.O0 = MRG; }
            S.lda = g.lda; S.K = g.K;

#ifndef NO_GEMM
pg8::gemm_phase<EpiStore, USched, true>(lds, g, S, E, tid);
#endif

        } else if (k == 3) {
            pg8::Gemm g; g.A = ZH; g.Bt = Wm_t; g.lda = LDZ; g.K = D;
            USched S; S.G = G; S.c = bx; S.mode = 2; S.nM0 = 128; S.nN0 = 4; S.nM1 = 0; S.nN1 = 0; S.a1off = 0; S.b1off = 0; S.a0col = 0; S.lda = LDZ; S.K = D;
            EpiMerge E; E.Z = ZH; E.MRG = MRG; E.gbias = a.in[4] + (size_t)l * DIN + 4624;

#ifndef NO_MERGE
pg8::gemm_phase<EpiMerge, USched, true>(lds, g, S, E, tid);
#endif

        } else if (k == 2) {
            unsigned* ctr = (unsigned*)(ws + WS_CTL) + 64 * (l + 1);
            LAS int* qslot = (LAS int*)(lds + LDS_BYTES - 64);
            const float* convw = a.in[5] + (size_t)l * 4 * 1024; const float* mg = a.in[6] + (size_t)l * 512; const float* gnorm = a.in[7] + (size_t)l * 512;
            const float* gws = a.in[8] + (size_t)l * 4 * 128 * 128; const float* gbs = a.in[9] + (size_t)l * 4 * 128;
            for (;;) {
                __syncthreads();
                if (tid == 0) *qslot = (int)atomicAdd(ctr, 1u);
                __syncthreads();
                const int it = __builtin_amdgcn_readfirstlane(*qslot);
                if (it >= 64 + 2048 + 1024) break;
                if (it < 64) {
#ifndef NO_MLSTM
mlstm_item(lds, ZH, convw, mg, it >> 2, it & 3, tid);
#endif
}
                else if (it < 64 + 2048) { const int r = it - 64; const int qb = 15 - (r >> 7), bh = r & 127;
#ifndef NO_FOX
fox_item(lds, ZH, bh >> 3, bh & 7, qb, tid);
#endif
 }
                else { const int r = it - 2112; const int gg = r & 3, sp = (r >> 2) & 15, bb = r >> 6;
#ifndef NO_GMLP
gmlp_item(lds, ZH, gnorm, gws + (size_t)gg * 128 * 128, gbs + gg * 128, bb, sp, gg, tid);
#endif
 }
            }
        } else if (k == 7) {

#ifndef NO_XATTN
for (int it = bx; it < 1024; it += G) xattn_item(lds, QB, KVb, OB, it >> 6, (it >> 4) & 3, it & 15, tid);
#endif

        } else if (k == 5) {
            norm_rows(l == 0 ? x_in : xout, xout, Y_A, gl + 1 * D, gl + 2 * D, H2A, D, MTOK, gw, NGW, lane);
            norm_rows(mem, nullptr, nullptr, nullptr, gl + 4 * D, MEMN, D, MEMR, gw, NGW, lane);
        } else if (k == 9) {
            norm_rows(xout, xout, MRG, gl + 3 * D, gl + 5 * D, H2B, D, MTOK, gw, NGW, lane);
        } else {
            if (l + 1 < DEPTH) {
                norm_rows(xout, xout, MRG, gl + 6 * D, norms + (size_t)(l + 1) * 7 * D, ZH + HCOL, LDZ, MTOK, gw, NGW, lane);
                const int n = l + 1;
                LayerW L{a.in[3] + (size_t)n * D * DIN, a.in[4] + (size_t)n * DIN, a.in[10] + (size_t)n * 3 * 512 * 1024, a.in[11] + (size_t)n * D * D, a.in[12] + (size_t)n * D * D,
                         a.in[13] + (size_t)n * D * 2 * D, a.in[14] + (size_t)n * D * D, a.in[15] + (size_t)n * D * DFF, a.in[16] + (size_t)n * DFF * D};
                convert_weights(L, ws, lds, gw, NGW, wave, lane, gtid, NGT);
            } else {
                norm_rows(xout, xout, MRG, gl + 6 * D, nullptr, nullptr, 0, MTOK, gw, NGW, lane);
            }
        }
    }
    }
}

extern "C" void kernel_launch(void* const* d_in, const int* in_sizes, int n_in, void* d_out, int out_size, void* d_ws, size_t ws_size, hipStream_t stream) {
    static int grid = 0;
    if (grid == 0) {
        if (n_in != 17 || ws_size < WS_END) { fprintf(stderr, "kernel_launch: unexpected n_in %d or ws_size %zu (< %zu)\n", n_in, ws_size, (size_t)WS_END); grid = -1; return; }
        int dev = 0, cus = 0, per_cu = 0;
        (void)hipGetDevice(&dev);
        (void)hipDeviceGetAttribute(&cus, hipDeviceAttributeMultiprocessorCount, dev);
        if (hipFuncSetAttribute((const void*)fwd_kernel, hipFuncAttributeMaxDynamicSharedMemorySize, LDS_BYTES) != hipSuccess) { fprintf(stderr, "kernel_launch: hipFuncSetAttribute failed\n"); }
        if (hipOccupancyMaxActiveBlocksPerMultiprocessor(&per_cu, (const void*)fwd_kernel, 512, LDS_BYTES) != hipSuccess || per_cu < 1) { fprintf(stderr, "kernel_launch: occupancy query says %d\n", per_cu); per_cu = 1; }
        (void)hipGetLastError();
        if (cus <= 0) cus = 256;
        if (cus < 256) fprintf(stderr, "kernel_launch: device reports %d CUs; this kernel is built for a 256-workgroup cooperative grid\n", cus);
        grid = 256;
    }
    if (grid < 0) return;
    (void)hipMemsetAsync((char*)d_ws + WS_CTL, 0, 4096, stream);
    Args a{};
    for (int i = 0; i < 17; ++i) a.in[i] = (const float*)d_in[i];
    a.out = (float*)d_out; a.ws = (unsigned char*)d_ws;
#if MK_MULTI
    for (int ph = 0; ph < NPHASE; ++ph) {
        a.ph_lo = ph; a.ph_hi = ph + 1;
        hipLaunchKernelGGL(fwd_kernel, dim3(grid), dim3(512), LDS_BYTES, stream, a);
    }
#else
    a.ph_lo = 0; a.ph_hi = NPHASE;
    void* args[] = {&a};
    hipError_t e = hipLaunchCooperativeKernel((const void*)fwd_kernel, dim3(grid), dim3(512), args, LDS_BYTES, stream);
    if (e != hipSuccess) fprintf(stderr, "cooperative launch failed: %s (grid %d)\n", hipGetErrorString(e), grid);
#endif
}
```

```cpp
#include <hip/hip_runtime.h>
#include <hip/hip_cooperative_groups.h>
#include <cstdio>
#include <cstdint>
namespace cg = cooperative_groups;

#ifndef MK_MULTI
#define MK_MULTI 0
#endif

#ifndef PROF_LO
#define PROF_LO -1
#define PROF_HI -1
#endif
#define LAS __attribute__((address_space(3)))
typedef unsigned short bf16_t;
typedef short bf16x8 __attribute__((ext_vector_type(8)));
typedef float f32x4 __attribute__((ext_vector_type(4)));
typedef unsigned u32x4 __attribute__((ext_vector_type(4)));
typedef unsigned u32x2 __attribute__((ext_vector_type(2)));
typedef float f32x2_t __attribute__((ext_vector_type(2)));
typedef __bf16 bf16x2_t __attribute__((ext_vector_type(2)));

namespace pg8 {
#define PG8_LAS __attribute__((address_space(3)))
constexpr int BM = 256, BK = 64, HALF = 128, HTB = HALF * BK * 2, STAGE_BYTES = 8 * HTB, NXCD = 8, WGM = 8;

__host__ __device__ __forceinline__ int lds_byte(int r, int c) { const int st = (r >> 4) * 2 + (c >> 5), rr = r & 15, cc = c & 31, ob = rr * 64 + cc * 2; return st * 1024 + (ob ^ (((ob >> 9) & 1) << 5)); }
__host__ __device__ __forceinline__ void stage_rc(int b, int& R, int& C) { const int st = b / 1024, sb = b % 1024, swz = sb ^ (((sb >> 9) & 1) << 5); R = (st >> 1) * 16 + swz / 64; C = (st & 1) * 32 + (swz % 64) / 2; }
__host__ __device__ __forceinline__ int perm32(int rho) { const int n = rho >> 4, i = rho & 15; return 8 * (i >> 2) + 4 * n + (i & 3); }

struct Unit { int pm, pn, sub, nt; long aoff, boff; };
struct Gemm { const bf16_t* A; const bf16_t* Bt; int lda, K; };

template <class Epi, class Sched, bool ALIGN_EPI>
__device__ __forceinline__ void gemm_phase(PG8_LAS unsigned char* lds, const Gemm g, const Sched& S, const Epi& E, int tid) {
    asm volatile("" : "+v"(tid));
    const int wid = __builtin_amdgcn_readfirstlane(tid >> 6), lane = tid & 63, wr = wid >> 2, wc = wid & 3, fr = lane & 15, fq = lane >> 4;
    const int K = g.K, lda = g.lda;
    unsigned voffA[2], voffB[2];
#pragma unroll
    for (int i = 0; i < 2; ++i) { int R, C; stage_rc(tid * 16 + i * 8192, R, C); const int Rb = Epi::PERM ? ((R & ~31) + perm32(R & 31)) : R;
        voffA[i] = (unsigned)(R * lda + C) * 2u; voffB[i] = (unsigned)(Rb * K + C) * 2u; }
    const size_t kstep = (size_t)(BK * 2);
    const size_t hstepA = (size_t)HALF * lda * 2, hstepB = (size_t)HALF * K * 2;
    const unsigned ldsw = (unsigned)wid * 1024u;
    const int aoff = lds_byte(wr * 64 + fr, fq * 8), boff = lds_byte(wc * 32 + fr, fq * 8);
#define PG8_SA(b, h) (((b) * 2 + (h)) * HTB)
#define PG8_SB(b, h) ((4 + (b) * 2 + (h)) * HTB)
#define PG8_STAGE(bufoff, gbase, voff) do { _Pragma("unroll") for (int _i = 0; _i < 2; ++_i) \
        __builtin_amdgcn_global_load_lds((const unsigned*)((const char*)(gbase) + (voff)[_i]), (PG8_LAS unsigned*)(lds + (bufoff) + ldsw + _i * 8192), 16, 0, 0); } while (0)
#define PG8_LDA(dst, b, h) do { _Pragma("unroll") for (int m = 0; m < 4; ++m) _Pragma("unroll") for (int k = 0; k < 2; ++k) dst[m][k] = *(const PG8_LAS bf16x8*)(lds + PG8_SA(b, h) + aoff + m * 2048 + k * 1024); } while (0)
#define PG8_LDB(dst, b, h) do { _Pragma("unroll") for (int n = 0; n < 2; ++n) _Pragma("unroll") for (int k = 0; k < 2; ++k) dst[n][k] = *(const PG8_LAS bf16x8*)(lds + PG8_SB(b, h) + boff + n * 2048 + k * 1024); } while (0)
#define PG8_MMA(ai, bj, At, Bt) do { __builtin_amdgcn_s_setprio(1); _Pragma("unroll") for (int m = 0; m < 4; ++m) _Pragma("unroll") for (int n = 0; n < 2; ++n) _Pragma("unroll") for (int k = 0; k < 2; ++k) \
        acc[ai][bj][m][n] = __builtin_amdgcn_mfma_f32_16x16x32_bf16(Bt[n][k], At[m][k], acc[ai][bj][m][n], 0, 0, 0); __builtin_amdgcn_s_setprio(0); } while (0)
#define PG8_WAIT_V(n) asm volatile("s_waitcnt vmcnt(" #n ")" ::: "memory")
#define PG8_WAIT_L(n) asm volatile("s_waitcnt lgkmcnt(" #n ")" ::: "memory")
#define PG8_BAR __builtin_amdgcn_s_barrier()
#define PG8_SCHED __builtin_amdgcn_sched_barrier(0)
    Unit cur, nxt; int ui = 0;
    if (!S.next(0, cur)) return;
    int nt = cur.nt;
    f32x4 acc[2][2][4][2];
#pragma unroll
    for (int a = 0; a < 2; ++a)
#pragma unroll
        for (int b = 0; b < 2; ++b)
#pragma unroll
            for (int m = 0; m < 4; ++m)
#pragma unroll
                for (int n = 0; n < 2; ++n) acc[a][b][m][n] = (f32x4){0.f, 0.f, 0.f, 0.f};
    bf16x8 At[4][2], B0[2][2], B1[2][2];
    const char* cA = (const char*)g.A + cur.aoff * 2; const char* cB = (const char*)g.Bt + cur.boff * 2;
    PG8_STAGE(PG8_SB(0, 0), cB, voffB); PG8_STAGE(PG8_SB(0, 1), cB + hstepB, voffB); PG8_STAGE(PG8_SA(0, 0), cA, voffA); PG8_STAGE(PG8_SA(0, 1), cA + hstepA, voffA);
    if (wr == 1) PG8_BAR;
    PG8_WAIT_V(2); PG8_BAR;
    PG8_STAGE(PG8_SB(1, 0), cB + kstep, voffB); PG8_STAGE(PG8_SA(1, 0), cA + kstep, voffA); PG8_STAGE(PG8_SB(1, 1), cB + hstepB + kstep, voffB);
    PG8_WAIT_V(6); PG8_BAR;
    for (;;) {
        const bool has_next = S.next(ui + 1, nxt);
        const char* nA = has_next ? (const char*)g.A + nxt.aoff * 2 : cA; const char* nB = has_next ? (const char*)g.Bt + nxt.boff * 2 : cB;
        for (int t = 0; t < nt; t += 2) {
            const bool last = (t == nt - 2);
            const char* a1 = cA + (size_t)(t + 1) * kstep;
            const char* a2 = last ? nA : cA + (size_t)(t + 2) * kstep; const char* b2 = last ? nB : cB + (size_t)(t + 2) * kstep;
            const char* a3 = a2 + kstep; const char* b3 = b2 + kstep;
            PG8_LDB(B0, 0, 0); PG8_LDB(B1, 0, 1); PG8_SCHED; PG8_LDA(At, 0, 0); PG8_STAGE(PG8_SA(1, 1), a1 + hstepA, voffA);
            PG8_WAIT_V(8); PG8_WAIT_L(0); PG8_BAR; PG8_MMA(0, 0, At, B0); PG8_MMA(0, 1, At, B1); PG8_BAR; PG8_SCHED;
            PG8_LDA(At, 0, 1); PG8_STAGE(PG8_SB(0, 0), b2, voffB); PG8_STAGE(PG8_SB(0, 1), b2 + hstepB, voffB); PG8_STAGE(PG8_SA(0, 0), a2, voffA);
            PG8_WAIT_V(8); PG8_WAIT_L(0); PG8_BAR; PG8_MMA(1, 0, At, B0); PG8_MMA(1, 1, At, B1); PG8_BAR; PG8_SCHED;
            PG8_LDB(B0, 1, 0); PG8_LDB(B1, 1, 1); PG8_SCHED; PG8_LDA(At, 1, 0); PG8_STAGE(PG8_SA(0, 1), a2 + hstepA, voffA);
            PG8_WAIT_V(8); PG8_WAIT_L(0); PG8_BAR; PG8_MMA(0, 0, At, B0); PG8_MMA(0, 1, At, B1); PG8_BAR; PG8_SCHED;
            PG8_LDA(At, 1, 1); PG8_STAGE(PG8_SB(1, 0), b3, voffB); PG8_STAGE(PG8_SB(1, 1), b3 + hstepB, voffB); PG8_STAGE(PG8_SA(1, 0), a3, voffA);
            PG8_WAIT_V(8); PG8_WAIT_L(0); PG8_BAR; PG8_MMA(1, 0, At, B0); PG8_MMA(1, 1, At, B1); PG8_BAR; PG8_SCHED;
        }
        if constexpr (ALIGN_EPI) { if (wr == 0) PG8_BAR; }
        E(acc, cur, wr, wc, fr, fq);
        if (!has_next) break;
#pragma unroll
        for (int a = 0; a < 2; ++a)
#pragma unroll
            for (int b = 0; b < 2; ++b)
#pragma unroll
                for (int m = 0; m < 4; ++m)
#pragma unroll
                    for (int n = 0; n < 2; ++n) acc[a][b][m][n] = (f32x4){0.f, 0.f, 0.f, 0.f};
        cur = nxt; cA = nA; cB = nB; ++ui; nt = cur.nt;
        if constexpr (ALIGN_EPI) { if (wr == 1) PG8_BAR; }
    }
    PG8_WAIT_V(0);
    if constexpr (!ALIGN_EPI) { if (wr == 0) PG8_BAR; }
    PG8_BAR;
#undef PG8_SA
#undef PG8_SB
#undef PG8_STAGE
#undef PG8_LDA
#undef PG8_LDB
#undef PG8_MMA
#undef PG8_WAIT_V
#undef PG8_WAIT_L
#undef PG8_BAR
#undef PG8_SCHED
}
}

constexpr int D = 1024, BATCH = 16, SEQ = 2048, MTOK = BATCH * SEQ, DEPTH = 2, MEMR = 16 * 256, DFF = 4096, DIN = 7696;
constexpr int LDZ = 5888, HCOL = 4864;
constexpr int ZC_FQ = 0, ZC_FK = 512, ZC_FV = 1024, ZC_MQ = 1536, ZC_MK = 2048, ZC_MV = 2560, ZC_MO = 3072, ZC_GU = 3584, ZC_GV = 4096, ZC_SM = 4608;
constexpr int ZC_SCR = 1024;
constexpr float EPS = 1e-6f;
constexpr int NPHASE = 25;
constexpr int LDS_BYTES = 147456;

constexpr size_t MiB = 1u << 20;
constexpr size_t WS_CTL = 0;
constexpr size_t WS_WIN = 1 * MiB;
constexpr size_t WS_WM = WS_WIN + (size_t)4864 * 1024 * 2;
constexpr size_t WS_WO = WS_WM + (size_t)6144 * 1024 * 2;
constexpr size_t WS_WXQ = WS_WO + 2 * MiB;
constexpr size_t WS_WXKV = WS_WXQ + 2 * MiB;
constexpr size_t WS_WXO = WS_WXKV + 4 * MiB;
constexpr size_t WS_W1 = WS_WXO + 2 * MiB;
constexpr size_t WS_W2 = WS_W1 + 8 * MiB;
constexpr size_t WS_BIASZ = WS_W2 + 8 * MiB;
constexpr size_t WS_KV = 50 * MiB;
constexpr size_t WS_MEMN = 66 * MiB;
constexpr size_t WS_ZH = 74 * MiB;
constexpr size_t WS_MRG = 442 * MiB;
constexpr size_t WS_END = 506 * MiB;
static_assert(WS_BIASZ + 4864 * 4 <= WS_KV, "ws map");

__device__ __forceinline__ float bf_lo(unsigned u) { return __uint_as_float(u << 16); }
__device__ __forceinline__ float bf_hi(unsigned u) { return __uint_as_float(u & 0xffff0000u); }
__device__ __forceinline__ float bf2f(bf16_t b) { return __uint_as_float(((unsigned)b) << 16); }
__device__ __forceinline__ unsigned pk2(float lo, float hi) { f32x2_t v = {lo, hi}; bf16x2_t b = __builtin_convertvector(v, bf16x2_t); return __builtin_bit_cast(unsigned, b); }
__device__ __forceinline__ bf16_t f2bf(float f) { return (bf16_t)(pk2(f, 0.f) & 0xffffu); }
__device__ __forceinline__ float shidx(float v, int src) { return __int_as_float(__builtin_amdgcn_ds_bpermute(src << 2, __float_as_int(v))); }
__device__ __forceinline__ float shx(float v, int m, int lane) { return shidx(v, lane ^ m); }
__device__ __forceinline__ float shup(float v, int o, int lane) { return shidx(v, (lane - o) & 63); }
__device__ __forceinline__ float wave_sum(float v, int lane) {
#pragma unroll
    for (int o = 1; o < 64; o <<= 1) v += shx(v, o, lane);
    return v;
}
__device__ __forceinline__ float frcp(float x) { return __builtin_amdgcn_rcpf(x); }
__device__ __forceinline__ float frsq(float x) { return __builtin_amdgcn_rsqf(x); }
__device__ __forceinline__ float sigmoidf_(float x) { return frcp(1.f + __expf(-x)); }
__device__ __forceinline__ float logsigmoidf_(float x) { return fminf(x, 0.f) - __logf(1.f + __expf(-fabsf(x))); }
__device__ __forceinline__ float gelu_tanh(float x) { const float u = 0.7978845608028654f * (x + 0.044715f * x * x * x); const float t = 1.f - 2.f * frcp(__expf(2.f * u) + 1.f); return 0.5f * x * (1.f + t); }
#define MFMA16(a, b, c) __builtin_amdgcn_mfma_f32_16x16x32_bf16((a), (b), (c), 0, 0, 0)
__device__ __forceinline__ bf16x8 frag(const LAS bf16_t* p, int ld, int row0, int k0, int lane) { return *(const LAS bf16x8*)(p + (row0 + (lane & 15)) * ld + k0 + (lane >> 4) * 8); }
#define LDS_FENCE() asm volatile("s_waitcnt lgkmcnt(0)" ::: "memory")

__device__ __forceinline__ void tile_map(int wgid, int nM, int nN, int& pm, int& pn) {
    const int nwg = nM * nN;
    { const int q = nwg / pg8::NXCD, r = nwg % pg8::NXCD, xcd = wgid % pg8::NXCD, off = wgid / pg8::NXCD; wgid = (xcd < r ? xcd * (q + 1) : r * (q + 1) + (xcd - r) * q) + off; }
    const int nig = pg8::WGM * nN, gid = wgid / nig, fm = gid * pg8::WGM, gsz = (nM - fm) < pg8::WGM ? (nM - fm) : pg8::WGM;
    pm = fm + ((wgid % nig) % gsz); pn = (wgid % nig) / gsz;
}
struct USched {
    int mode;
    int G, c, nM0, nN0, nM1, nN1;
    long lda, K, a0col, a1off, b1off;
    __device__ __forceinline__ bool next(int i, pg8::Unit& u) const {
        if (mode == 2) {
            const int ti = i / 6, s = i - ti * 6; const long L = (long)ti * G + c; if (L >= (long)nM0 * nN0) return false;
            int pm, pn; tile_map((int)L, nM0, nN0, pm, pn);
            const int n = s >> 1, br = s & 1;
            const long acol = br ? (n == 0 ? (long)ZC_FQ : (n == 1 ? (long)ZC_MO : (long)ZC_GU)) : (long)HCOL;
            u.pm = pm; u.pn = pn; u.sub = s; u.nt = br ? 8 : 16; u.aoff = (long)pm * 256 * lda + acol; u.boff = ((long)(br ? 3072 : 0) + n * 1024 + pn * 256) * K; return true;
        }
        const long L = (long)i * G + c; const long n0 = (long)nM0 * nN0;
        if (L < n0) { int pm, pn; tile_map((int)L, nM0, nN0, pm, pn); u.pm = pm; u.pn = pn; u.sub = 0; u.nt = (int)(K >> 6); u.aoff = (long)pm * 256 * lda + a0col; u.boff = (long)pn * 256 * K; return true; }
        if (mode == 1 && L < n0 + (long)nM1 * nN1) { int pm, pn; tile_map((int)(L - n0), nM1, nN1, pm, pn); u.pm = pm; u.pn = pn; u.sub = 1; u.nt = (int)(K >> 6); u.aoff = a1off + (long)pm * 256 * lda; u.boff = b1off + (long)pn * 256 * K; return true; }
        return false;
    }
};

struct EpiStore {
    static constexpr bool PERM = true;
    bf16_t* O0; bf16_t* O1; bf16_t* VT; int ldc0, ldc1, act; const float* bias;
    __device__ __forceinline__ void operator()(const f32x4 (&acc)[2][2][4][2], const pg8::Unit& u, int wr, int wc, int fr, int fq) const {
        bf16_t* base = u.sub ? O1 : O0; const int ldc = u.sub ? ldc1 : ldc0;
        const int row0 = u.pm * 256 + wr * 64 + fr, col0 = u.pn * 256 + wc * 32 + 8 * fq;
        if (u.sub && u.pn >= 4) {
#pragma unroll
            for (int ai = 0; ai < 2; ++ai)
#pragma unroll
                for (int m = 0; m < 4; ++m) { const int r = row0 + ai * 128 + m * 16; bf16_t* vp = VT + ((size_t)(r >> 8) * 1024 + (col0 - 1024)) * 256 + (r & 255);
#pragma unroll
                    for (int bj = 0; bj < 2; ++bj)
#pragma unroll
                        for (int n = 0; n < 2; ++n)
#pragma unroll
                            for (int e = 0; e < 4; ++e) vp[(size_t)(bj * 128 + n * 4 + e) * 256] = f2bf(acc[ai][bj][m][n][e]); }
            return;
        }
        f32x4 bv[2][2];
#pragma unroll
        for (int bj = 0; bj < 2; ++bj)
#pragma unroll
            for (int n = 0; n < 2; ++n) bv[bj][n] = bias ? *(const f32x4*)(bias + col0 + bj * 128 + 4 * n) : (f32x4){0.f, 0.f, 0.f, 0.f};
#pragma unroll
        for (int ai = 0; ai < 2; ++ai)
#pragma unroll
            for (int m = 0; m < 4; ++m) { bf16_t* rowp = base + (size_t)(row0 + ai * 128 + m * 16) * ldc + col0;
#pragma unroll
                for (int bj = 0; bj < 2; ++bj) { f32x4 v0 = acc[ai][bj][m][0] + bv[bj][0], v1 = acc[ai][bj][m][1] + bv[bj][1];
                    if (act == 2) {
#pragma unroll
                        for (int e = 0; e < 4; ++e) { const float a0 = fmaxf(v0[e], 0.f), a1 = fmaxf(v1[e], 0.f); v0[e] = a0 * a0; v1[e] = a1 * a1; } }
                    u32x4 w; w.x = pk2(v0[0], v0[1]); w.y = pk2(v0[2], v0[3]); w.z = pk2(v1[0], v1[1]); w.w = pk2(v1[2], v1[3]);
                    *(u32x4*)(rowp + bj * 128) = w; } }
    }
};
struct EpiMerge {
    static constexpr bool PERM = true, FUSED = false;
    bf16_t* Z; bf16_t* MRG; const float* gbias;
    __device__ __forceinline__ void operator()(const f32x4 (&acc)[2][2][4][2], const pg8::Unit& u, int wr, int wc, int fr, int fq) const {
        const int n = u.sub >> 1, br = u.sub & 1;
        const int row0 = u.pm * 256 + wr * 64 + fr, col0 = u.pn * 256 + wc * 32 + 8 * fq;
        if (!br) {
            f32x4 gb[2][2];
#pragma unroll
            for (int bj = 0; bj < 2; ++bj) { gb[bj][0] = *(const f32x4*)(gbias + n * 1024 + col0 + bj * 128); gb[bj][1] = *(const f32x4*)(gbias + n * 1024 + col0 + bj * 128 + 4); }
#pragma unroll
            for (int ai = 0; ai < 2; ++ai)
#pragma unroll
                for (int m = 0; m < 4; ++m) { bf16_t* sp = Z + (size_t)(row0 + ai * 128 + m * 16) * LDZ + ZC_SCR + col0;
#pragma unroll
                    for (int bj = 0; bj < 2; ++bj) { f32x4 v0 = acc[ai][bj][m][0], v1 = acc[ai][bj][m][1];
#pragma unroll
                        for (int e = 0; e < 4; ++e) { v0[e] = sigmoidf_(v0[e] + gb[bj][0][e]); v1[e] = sigmoidf_(v1[e] + gb[bj][1][e]); }
                        u32x4 w; w.x = pk2(v0[0], v0[1]); w.y = pk2(v0[2], v0[3]); w.z = pk2(v1[0], v1[1]); w.w = pk2(v1[2], v1[3]);
                        *(u32x4*)(sp + bj * 128) = w; } }
        } else {
#pragma unroll
            for (int ai = 0; ai < 2; ++ai) {
                u32x4 sv[4][2], qv[4][2];
#pragma unroll
                for (int m = 0; m < 4; ++m) { const size_t row = (size_t)(row0 + ai * 128 + m * 16);
#pragma unroll
                    for (int bj = 0; bj < 2; ++bj) { sv[m][bj] = *(const u32x4*)(Z + row * LDZ + ZC_SCR + col0 + bj * 128);
                        qv[m][bj] = (n > 0) ? *(const u32x4*)(MRG + row * D + col0 + bj * 128) : (u32x4){0u, 0u, 0u, 0u}; } }
#pragma unroll
                for (int m = 0; m < 4; ++m) { bf16_t* mp = MRG + (size_t)(row0 + ai * 128 + m * 16) * D + col0;
#pragma unroll
                    for (int bj = 0; bj < 2; ++bj) { f32x4 v0 = acc[ai][bj][m][0], v1 = acc[ai][bj][m][1]; const u32x4 s = sv[m][bj], q = qv[m][bj];
                        v0[0] = v0[0] * bf_lo(s.x) + bf_lo(q.x); v0[1] = v0[1] * bf_hi(s.x) + bf_hi(q.x); v0[2] = v0[2] * bf_lo(s.y) + bf_lo(q.y); v0[3] = v0[3] * bf_hi(s.y) + bf_hi(q.y);
                        v1[0] = v1[0] * bf_lo(s.z) + bf_lo(q.z); v1[1] = v1[1] * bf_hi(s.z) + bf_hi(q.z); v1[2] = v1[2] * bf_lo(s.w) + bf_lo(q.w); v1[3] = v1[3] * bf_hi(s.w) + bf_hi(q.w);
                        u32x4 w; w.x = pk2(v0[0], v0[1]); w.y = pk2(v0[2], v0[3]); w.z = pk2(v1[0], v1[1]); w.w = pk2(v1[2], v1[3]);
                        *(u32x4*)(mp + bj * 128) = w; } }
            }
        }
    }
};

__device__ __forceinline__ void norm_rows(const float* xsrc, float* xdst, const bf16_t* y, const float* gpost, const float* gpre, bf16_t* hout, int ldh, int nrows, int gw, int NGW, int lane) {
#pragma unroll 1
    for (int m = gw; m < nrows; m += 2 * NGW) {
        f32x4 v[2][4];
#pragma unroll
        for (int q = 0; q < 2; ++q) { const f32x4* xr = (const f32x4*)(xsrc + (size_t)(m + q * NGW) * D) + lane;
#pragma unroll
            for (int j = 0; j < 4; ++j) v[q][j] = xr[64 * j]; }
        if (y) {
            f32x4 yv[2][4]; float ss[2];
#pragma unroll
            for (int q = 0; q < 2; ++q) { const u32x2* yr = (const u32x2*)(y + (size_t)(m + q * NGW) * D) + lane; ss[q] = 0.f;
#pragma unroll
                for (int j = 0; j < 4; ++j) { const u32x2 t = yr[64 * j]; yv[q][j] = (f32x4){bf_lo(t.x), bf_hi(t.x), bf_lo(t.y), bf_hi(t.y)};
                    ss[q] += (yv[q][j][0] * yv[q][j][0] + yv[q][j][1] * yv[q][j][1]) + (yv[q][j][2] * yv[q][j][2] + yv[q][j][3] * yv[q][j][3]); } }
#pragma unroll
            for (int q = 0; q < 2; ++q) { const float r = frsq(wave_sum(ss[q], lane) * (1.f / D) + EPS);
                f32x4* xo = (f32x4*)(xdst + (size_t)(m + q * NGW) * D) + lane;
#pragma unroll
                for (int j = 0; j < 4; ++j) { const f32x4 gp = ((const f32x4*)gpost)[lane + 64 * j]; v[q][j] = v[q][j] + yv[q][j] * r * gp; xo[64 * j] = v[q][j]; } }
        }
        if (hout) {
#pragma unroll
            for (int q = 0; q < 2; ++q) { float ss = 0.f;
#pragma unroll
                for (int j = 0; j < 4; ++j) ss += (v[q][j][0] * v[q][j][0] + v[q][j][1] * v[q][j][1]) + (v[q][j][2] * v[q][j][2] + v[q][j][3] * v[q][j][3]);
                const float r = frsq(wave_sum(ss, lane) * (1.f / D) + EPS);
                u32x2* ho = (u32x2*)(hout + (size_t)(m + q * NGW) * ldh) + lane;
#pragma unroll
                for (int j = 0; j < 4; ++j) { const f32x4 gp = ((const f32x4*)gpre)[lane + 64 * j]; const f32x4 o = v[q][j] * r * gp; u32x2 w; w.x = pk2(o[0], o[1]); w.y = pk2(o[2], o[3]); ho[64 * j] = w; } }
        }
    }
}

__device__ __forceinline__ void tr_item(const float* W, int ldw, int col0, bf16_t* WT, int ldt, int row0, int nblk, LAS float* scr, int item, int lane) {
    const int kb = item / nblk, nb = item % nblk, k0 = 64 * kb, n0 = 32 * nb;
#pragma unroll
    for (int i = 0; i < 8; ++i) { const int kk = 8 * i + (lane >> 3); const f32x4 v = *(const f32x4*)(W + (size_t)(k0 + kk) * ldw + col0 + n0 + (lane & 7) * 4);
        LAS float* d = scr + kk * 33 + (lane & 7) * 4; d[0] = v[0]; d[1] = v[1]; d[2] = v[2]; d[3] = v[3]; }
    LDS_FENCE();
    const int c = lane & 7;
#pragma unroll
    for (int j = 0; j < 4; ++j) { const int n = (lane >> 3) + 8 * j; const LAS float* s = scr + (8 * c) * 33 + n;
        u32x4 o; o.x = pk2(s[0 * 33], s[1 * 33]); o.y = pk2(s[2 * 33], s[3 * 33]); o.z = pk2(s[4 * 33], s[5 * 33]); o.w = pk2(s[6 * 33], s[7 * 33]);
        *(u32x4*)(WT + (size_t)(row0 + n0 + n) * ldt + k0 + 8 * c) = o; }
    LDS_FENCE();
}
__device__ __forceinline__ int small_src(int i) { return i < 8 ? 1536 + i : (i < 12 ? 3080 + (i - 8) : 3084 + (i - 12)); }
struct LayerW { const float *w_in, *b_in, *w_branch, *w_out, *w_xq, *w_xkv, *w_xo, *w_ff1, *w_ff2; };
__device__ __forceinline__ void convert_weights(const LayerW& L, unsigned char* ws, LAS unsigned char* lds, int gw, int NGW, int wave, int lane, int gtid, int NGT) {
    bf16_t* Win_t = (bf16_t*)(ws + WS_WIN); bf16_t* Wm_t = (bf16_t*)(ws + WS_WM); bf16_t* Wo_t = (bf16_t*)(ws + WS_WO); bf16_t* Wxq_t = (bf16_t*)(ws + WS_WXQ);
    bf16_t* Wxkv_t = (bf16_t*)(ws + WS_WXKV); bf16_t* Wxo_t = (bf16_t*)(ws + WS_WXO); bf16_t* W1_t = (bf16_t*)(ws + WS_W1); bf16_t* W2_t = (bf16_t*)(ws + WS_W2);
    float* biasz = (float*)(ws + WS_BIASZ);
    LAS float* scr = (LAS float*)(lds + wave * 16384);
    constexpr int NIT = 768 + 768 + 256 + 512 + 1536 + 3 * 256 + 512 + 512 + 1024 + 512 + 2048 + 2048;
#pragma unroll 1
    for (int it = gw; it < NIT; it += NGW) {
        int r = it;
        if (r < 768) { tr_item(L.w_in, DIN, 0, Win_t, 1024, 0, 48, scr, r, lane); continue; } r -= 768;
        if (r < 768) { tr_item(L.w_in, DIN, 1544, Win_t, 1024, 1536, 48, scr, r, lane); continue; } r -= 768;
        if (r < 256) { tr_item(L.w_in, DIN, 3088, Win_t, 1024, 3072, 16, scr, r, lane); continue; } r -= 256;
        if (r < 512) { tr_item(L.w_in, DIN, 3600, Win_t, 1024, 3584, 32, scr, r, lane); continue; } r -= 512;
        if (r < 1536) { tr_item(L.w_in, DIN, 4624, Wm_t, 1024, 0, 96, scr, r, lane); continue; } r -= 1536;
        if (r < 768) { const int n = r >> 8; tr_item(L.w_branch + (size_t)n * 512 * 1024, 1024, 0, Wm_t, 1024, 3072 + n * 1024, 32, scr, r & 255, lane); continue; } r -= 768;
        if (r < 512) { tr_item(L.w_out, 1024, 0, Wo_t, 1024, 0, 32, scr, r, lane); continue; } r -= 512;
        if (r < 512) { tr_item(L.w_xq, 1024, 0, Wxq_t, 1024, 0, 32, scr, r, lane); continue; } r -= 512;
        if (r < 1024) { tr_item(L.w_xkv, 2048, 0, Wxkv_t, 1024, 0, 64, scr, r, lane); continue; } r -= 1024;
        if (r < 512) { tr_item(L.w_xo, 1024, 0, Wxo_t, 1024, 0, 32, scr, r, lane); continue; } r -= 512;
        if (r < 2048) { tr_item(L.w_ff1, 4096, 0, W1_t, 1024, 0, 128, scr, r, lane); continue; } r -= 2048;
        tr_item(L.w_ff2, 1024, 0, W2_t, 4096, 0, 32, scr, r, lane);
    }
    const u32x4 z4 = {0u, 0u, 0u, 0u};
#pragma unroll 1
    for (int i = gtid; i < 3072 * 64; i += NGT) { const int row = i >> 6, c = i & 63; *(u32x4*)(Wm_t + (size_t)(3072 + row) * 1024 + 512 + c * 8) = z4; }
#pragma unroll 1
    for (int i = gtid; i < 240 * 128; i += NGT) { const int row = i >> 7, c = i & 127; *(u32x4*)(Win_t + (size_t)(4624 + row) * 1024 + c * 8) = z4; }
#pragma unroll 1
    for (int i = gtid; i < 16 * 1024; i += NGT) { const int j = i >> 10, k = i & 1023; Win_t[(size_t)(4608 + j) * 1024 + k] = f2bf(L.w_in[(size_t)k * DIN + small_src(j)]); }
#pragma unroll 1
    for (int c = gtid; c < 4864; c += NGT) {
        float v;
        if (c < 1536) v = L.b_in[c]; else if (c < 3072) v = L.b_in[1544 + c - 1536]; else if (c < 3584) v = L.b_in[3088 + c - 3072];
        else if (c < 4608) v = L.b_in[3600 + c - 3584]; else if (c < 4624) v = L.b_in[small_src(c - 4608)]; else v = 0.f;
        biasz[c] = v;
    }
}

constexpr float L2E = 1.4426950408889634f;
__device__ __forceinline__ void fox_softmax(f32x4 (&S)[4], float FtL, int qrow, int kt, bool needmask, LAS bf16_t* Ps, int fr, int fq) {
    if (needmask) {
        const int t = qrow + fr;
#pragma unroll
        for (int nt = 0; nt < 4; ++nt)
#pragma unroll
            for (int j = 0; j < 4; ++j) { const int key = kt * 64 + nt * 16 + fq * 4 + j; if (key > t) S[nt][j] = -INFINITY; }
    }
#pragma unroll
    for (int nt = 0; nt < 4; ++nt) {
        const float p0 = __builtin_amdgcn_exp2f(fmaf(S[nt][0], L2E, FtL)), p1 = __builtin_amdgcn_exp2f(fmaf(S[nt][1], L2E, FtL));
        const float p2 = __builtin_amdgcn_exp2f(fmaf(S[nt][2], L2E, FtL)), p3 = __builtin_amdgcn_exp2f(fmaf(S[nt][3], L2E, FtL));
        u32x2 o; o.x = pk2(p0, p1); o.y = pk2(p2, p3);
        *(LAS u32x2*)(Ps + fr * 72 + nt * 16 + fq * 4) = o; }
}
template <bool BOTH>
__device__ __forceinline__ void fox_tile(const LAS bf16_t* Kb, const LAS bf16_t* Vb, const LAS float* NFk, const bf16x8 (&qfA)[2], const bf16x8 (&qfB)[2], float FtLA, float FtLB,
                                         f32x4 (&OA)[5], f32x4 (&OB)[5], int qrowA, int qrowB, int kt, LAS bf16_t* PsA, LAS bf16_t* PsB, int lane, int fr, int fq) {
    f32x4 SA[4], SB[4];
#pragma unroll
    for (int nt = 0; nt < 4; ++nt) { const bf16x8 k0 = frag(Kb, 72, nt * 16, 0, lane), k1 = frag(Kb, 72, nt * 16, 32, lane);
        const f32x4 nf = *(const LAS f32x4*)(NFk + nt * 16 + fq * 4);
        SB[nt] = MFMA16(k0, qfB[0], nf); SB[nt] = MFMA16(k1, qfB[1], SB[nt]);
        if constexpr (BOTH) { SA[nt] = MFMA16(k0, qfA[0], nf); SA[nt] = MFMA16(k1, qfA[1], SA[nt]); } }
    fox_softmax(SB, FtLB, qrowB, kt, kt * 64 + 63 > qrowB, PsB, fr, fq);
    if constexpr (BOTH) fox_softmax(SA, FtLA, qrowA, kt, kt * 64 + 63 > qrowA, PsA, fr, fq);
    LDS_FENCE();
#pragma unroll
    for (int ks = 0; ks < 2; ++ks) { const bf16x8 pB = frag(PsB, 72, 0, ks * 32, lane); bf16x8 pA = pB; if constexpr (BOTH) pA = frag(PsA, 72, 0, ks * 32, lane);
#pragma unroll
        for (int nt = 0; nt < 5; ++nt) { const bf16x8 vf = frag(Vb, 72, nt * 16, ks * 32, lane);
            OB[nt] = MFMA16(vf, pB, OB[nt]); if constexpr (BOTH) OA[nt] = MFMA16(vf, pA, OA[nt]); } }
    LDS_FENCE();
}
__device__ __forceinline__ bf16x8 load_q_scaled(const bf16_t* p) {
    u32x4 r = *(const u32x4*)p;
    r.x = pk2(bf_lo(r.x) * 0.125f, bf_hi(r.x) * 0.125f); r.y = pk2(bf_lo(r.y) * 0.125f, bf_hi(r.y) * 0.125f);
    r.z = pk2(bf_lo(r.z) * 0.125f, bf_hi(r.z) * 0.125f); r.w = pk2(bf_lo(r.w) * 0.125f, bf_hi(r.w) * 0.125f);
    return __builtin_bit_cast(bf16x8, r);
}
__device__ __forceinline__ void fox_item(LAS unsigned char* lds, bf16_t* Z, int b, int h, int p, int tid) {
    asm volatile("" : "+v"(tid));
    const int lane = tid & 63, w = __builtin_amdgcn_readfirstlane(tid >> 6), fr = lane & 15, fq = lane >> 4;
    LAS float* NF = (LAS float*)lds;
    LAS float* wsum = (LAS float*)(lds + 8192);
    LAS bf16_t* Ks = (LAS bf16_t*)(lds + 8448);
    LAS bf16_t* Vt = Ks + 2 * 64 * 72;
    LAS bf16_t* PsA = Vt + 2 * 80 * 72 + w * 32 * 72;
    LAS bf16_t* PsB = PsA + 16 * 72;
    const int qbA = 2 * p, qbB = 2 * p + 1, q1 = (qbB + 1) * 128;
    const size_t rowbase = (size_t)b * SEQ;
    {
        float lf[4]; float run = 0.f;
#pragma unroll
        for (int i = 0; i < 4; ++i) { const int t = 4 * tid + i; float v = 0.f; if (t < q1) v = logsigmoidf_(bf2f(Z[(rowbase + t) * LDZ + ZC_SM + h])); run += v; lf[i] = run; }
        float sc = run;
#pragma unroll
        for (int o = 1; o < 64; o <<= 1) { const float nb = shup(sc, o, lane); if (lane >= o) sc += nb; }
        if (lane == 63) wsum[w] = sc;
        for (int i = tid; i < 2 * 16 * 72; i += 512) { const int bufi = i / (16 * 72), r = i % (16 * 72); Vt[bufi * 80 * 72 + 64 * 72 + r] = (r < 72) ? (bf16_t)0x3F80 : (bf16_t)0; }
        __syncthreads();
        float base = 0.f;
        for (int i = 0; i < w; ++i) base += wsum[i];
        const float excl = base + sc - run;
#pragma unroll
        for (int i = 0; i < 4; ++i) NF[4 * tid + i] = -(excl + lf[i]);
    }
    const int qrowA = qbA * 128 + w * 16, qrowB = qbB * 128 + w * 16;
    bf16x8 qfA[2], qfB[2];
#pragma unroll
    for (int ks = 0; ks < 2; ++ks) { qfA[ks] = load_q_scaled(Z + (rowbase + qrowA + fr) * LDZ + ZC_FQ + h * 64 + ks * 32 + fq * 8);
                                     qfB[ks] = load_q_scaled(Z + (rowbase + qrowB + fr) * LDZ + ZC_FQ + h * 64 + ks * 32 + fq * 8); }
    const bool vrole = tid < 256;
    const int su = tid & 255, skey = su >> 3, sdc = su & 7;
    const bf16_t* sbase = Z + rowbase * LDZ + h * 64 + sdc * 8 + (vrole ? (size_t)ZC_FV + (size_t)(2 * skey) * LDZ : (size_t)ZC_FK + (size_t)skey * LDZ);
    const size_t sstep = vrole ? (size_t)LDZ : (size_t)32 * LDZ;
    u32x4 r0, r1;
#define FOX_LOAD(kt_) do { const bf16_t* s_ = sbase + (size_t)(kt_) * 64 * LDZ; r0 = *(const u32x4*)s_; r1 = *(const u32x4*)(s_ + sstep); } while (0)
#define FOX_STORE(buf_) do { if (vrole) { LAS bf16_t* vp = Vt + (buf_) * 80 * 72 + (sdc * 8) * 72 + 2 * skey; \
        *(LAS unsigned*)(vp + 0 * 72) = (r0.x & 0xffffu) | (r1.x << 16); *(LAS unsigned*)(vp + 1 * 72) = (r0.x >> 16) | (r1.x & 0xffff0000u); \
        *(LAS unsigned*)(vp + 2 * 72) = (r0.y & 0xffffu) | (r1.y << 16); *(LAS unsigned*)(vp + 3 * 72) = (r0.y >> 16) | (r1.y & 0xffff0000u); \
        *(LAS unsigned*)(vp + 4 * 72) = (r0.z & 0xffffu) | (r1.z << 16); *(LAS unsigned*)(vp + 5 * 72) = (r0.z >> 16) | (r1.z & 0xffff0000u); \
        *(LAS unsigned*)(vp + 6 * 72) = (r0.w & 0xffffu) | (r1.w << 16); *(LAS unsigned*)(vp + 7 * 72) = (r0.w >> 16) | (r1.w & 0xffff0000u); } \
      else { *(LAS u32x4*)(Ks + (buf_) * 64 * 72 + skey * 72 + sdc * 8) = r0; *(LAS u32x4*)(Ks + (buf_) * 64 * 72 + (skey + 32) * 72 + sdc * 8) = r1; } } while (0)
    const int nkt = q1 / 64;
    FOX_LOAD(0); FOX_STORE(0); FOX_LOAD(1);
    __syncthreads();
    const float FtLA = -NF[qrowA + fr] * L2E, FtLB = -NF[qrowB + fr] * L2E;
    f32x4 OA[5], OB[5];
#pragma unroll
    for (int nt = 0; nt < 5; ++nt) { OA[nt] = (f32x4){0.f, 0.f, 0.f, 0.f}; OB[nt] = (f32x4){0.f, 0.f, 0.f, 0.f}; }
    for (int kt = 0; kt < nkt; ++kt) {
        const int buf = kt & 1;
        if (kt + 1 < nkt) { FOX_STORE(buf ^ 1); if (kt + 2 < nkt) FOX_LOAD(kt + 2); }
        const bool actB = kt * 64 <= qrowB + 15, actA = kt * 64 <= qrowA + 15;
        if (actB) {
            const LAS bf16_t* Kb = Ks + buf * 64 * 72; const LAS bf16_t* Vb = Vt + buf * 80 * 72;
            if (actA) fox_tile<true>(Kb, Vb, NF + kt * 64, qfA, qfB, FtLA, FtLB, OA, OB, qrowA, qrowB, kt, PsA, PsB, lane, fr, fq);
            else fox_tile<false>(Kb, Vb, NF + kt * 64, qfA, qfB, FtLA, FtLB, OA, OB, qrowA, qrowB, kt, PsA, PsB, lane, fr, fq);
        }
        __syncthreads();
    }
#undef FOX_LOAD
#undef FOX_STORE
    {
        const float iA = 1.f / shidx(OA[4][0], fr), iB = 1.f / shidx(OB[4][0], fr);
        bf16_t* pa = Z + (rowbase + qrowA + fr) * LDZ + ZC_FQ + h * 64 + fq * 4; bf16_t* pb = Z + (rowbase + qrowB + fr) * LDZ + ZC_FQ + h * 64 + fq * 4;
#pragma unroll
        for (int nt = 0; nt < 4; ++nt) { u32x2 o;
            o.x = pk2(OA[nt][0] * iA, OA[nt][1] * iA); o.y = pk2(OA[nt][2] * iA, OA[nt][3] * iA); *(u32x2*)(pa + nt * 16) = o;
            o.x = pk2(OB[nt][0] * iB, OB[nt][1] * iB); o.y = pk2(OB[nt][2] * iB, OB[nt][3] * iB); *(u32x2*)(pb + nt * 16) = o; } }
    __syncthreads();
}

__device__ __forceinline__ void mlstm_item(LAS unsigned char* lds, bf16_t* Z, const float* convw, const float* mg, int b, int h, int tid) {
    asm volatile("" : "+v"(tid));
    const int lane = tid & 63, w = __builtin_amdgcn_readfirstlane(tid >> 6), fr = lane & 15, fq = lane >> 4;
    LAS bf16_t* Qs = (LAS bf16_t*)lds;
    LAS bf16_t* Ks = Qs + 64 * 136;
    LAS bf16_t* KWt = Ks + 64 * 136;
    LAS bf16_t* Vt = KWt + 128 * 72;
    LAS bf16_t* Ct = Vt + 144 * 72;
    LAS bf16_t* Ps = Ct + 144 * 136;
    LAS float* GA = (LAS float*)(Ps + 64 * 72);
    LAS float* GM = GA + 64; LAS float* WI = GA + 128; LAS float* EN = GA + 192; LAS float* WS = GA + 256; LAS float* SC = GA + 320;
    LAS float* SSQ = GA + 336;
    LAS float* CW = GA + 464;
    LAS float* MGs = GA + 1488;
    const size_t rowbase = (size_t)b * SEQ;
    for (int i = tid; i < 144 * 136 / 2; i += 512) ((LAS unsigned*)Ct)[i] = 0u;
    for (int i = tid; i < 16 * 72; i += 512) Vt[128 * 72 + i] = (i < 72) ? (bf16_t)0x3F80 : (bf16_t)0;
    for (int i = tid; i < 1024; i += 512) { const int j = i >> 8, c = i & 255; CW[i] = convw[j * 1024 + (c < 128 ? h * 128 + c : 512 + h * 128 + (c - 128))]; }
    if (tid < 128) MGs[tid] = mg[h * 128 + tid];
    f32x4 Cacc[9];
#pragma unroll
    for (int nt = 0; nt < 9; ++nt) Cacc[nt] = (f32x4){0.f, 0.f, 0.f, 0.f};
    float mprev = 0.f;
    const int role = __builtin_amdgcn_readfirstlane(tid >> 8);
    const int su = tid & 255, tq = su >> 4, dc = su & 15;
    const int vt2 = tid >> 4, dcv = tid & 15;
    const int mt_t = w & 3, half = w >> 2, tl = mt_t * 16 + fr;
    const bf16_t* qkbase = Z + rowbase * LDZ + (role ? ZC_MK : ZC_MQ) + h * 128 + dc * 8;
    const bf16_t* vbase = Z + (rowbase + 2 * vt2) * LDZ + ZC_MV + h * 128 + dcv * 8;
    u32x4 rq[7], rv[2]; float gi = 0.f, gf = 0.f;
#define ML_LOAD(ch_) do { const int t0_ = (ch_) * 64; \
        _Pragma("unroll") for (int i = 0; i < 7; ++i) { const int tg = t0_ + 4 * tq - 3 + i; rq[i] = (u32x4){0u, 0u, 0u, 0u}; if (tg >= 0) rq[i] = *(const u32x4*)(qkbase + (size_t)tg * LDZ); } \
        rv[0] = *(const u32x4*)(vbase + (size_t)t0_ * LDZ); rv[1] = *(const u32x4*)(vbase + (size_t)(t0_ + 1) * LDZ); \
        if (w == 0) { const size_t row = rowbase + t0_ + lane; gi = bf2f(Z[row * LDZ + ZC_SM + 8 + h]); gf = bf2f(Z[row * LDZ + ZC_SM + 12 + h]); } } while (0)
    ML_LOAD(0);
    for (int ch = 0; ch < SEQ / 64; ++ch) {
        const int t0 = ch * 64;
        if (w == 0) {
            float bc = logsigmoidf_(gf);
#pragma unroll
            for (int o = 1; o < 64; o <<= 1) { const float nb = shup(bc, o, lane); if (lane >= o) bc += nb; }
            const float av = gi - bc;
            float gm = av;
#pragma unroll
            for (int o = 1; o < 64; o <<= 1) { const float nb = shup(gm, o, lane); if (lane >= o) gm = fmaxf(gm, nb); }
            const float mm = fmaxf(mprev, gm), mt = bc + mm;
            GA[lane] = av; GM[lane] = mm; WI[lane] = __expf(mprev - mm); EN[lane] = __expf(-mt);
            const float mm63 = shidx(mm, 63), b63 = shidx(bc, 63);
            WS[lane] = __expf(av - mm63);
            if (lane == 0) SC[0] = __expf(mprev - mm63);
            mprev = b63 + mm63;
        }
        __syncthreads();
        {
            u32x4 okp[4];
#pragma unroll
            for (int a = 0; a < 4; ++a) {
                float acc[8];
#pragma unroll
                for (int e = 0; e < 8; ++e) acc[e] = 0.f;
#pragma unroll
                for (int j = 0; j < 4; ++j) { const u32x4 r = rq[a + j];
                    const f32x4 c0 = *(const LAS f32x4*)(CW + j * 256 + role * 128 + dc * 8), c1 = *(const LAS f32x4*)(CW + j * 256 + role * 128 + dc * 8 + 4);
                    acc[0] += c0[0] * bf_lo(r.x); acc[1] += c0[1] * bf_hi(r.x); acc[2] += c0[2] * bf_lo(r.y); acc[3] += c0[3] * bf_hi(r.y);
                    acc[4] += c1[0] * bf_lo(r.z); acc[5] += c1[1] * bf_hi(r.z); acc[6] += c1[2] * bf_lo(r.w); acc[7] += c1[3] * bf_hi(r.w); }
                const float sc_ = role ? 0.08838834764831845f : 1.f;
#pragma unroll
                for (int e = 0; e < 8; ++e) acc[e] = acc[e] * sigmoidf_(acc[e]) * sc_;
                u32x4 o; o.x = pk2(acc[0], acc[1]); o.y = pk2(acc[2], acc[3]); o.z = pk2(acc[4], acc[5]); o.w = pk2(acc[6], acc[7]);
                *(LAS u32x4*)((role ? Ks : Qs) + (4 * tq + a) * 136 + dc * 8) = o;
                okp[a] = o;
                asm volatile("" ::: "memory");
            }
            if (role == 1) {
                const float w0 = WS[4 * tq], w1 = WS[4 * tq + 1], w2 = WS[4 * tq + 2], w3 = WS[4 * tq + 3];
                LAS bf16_t* kp = KWt + (dc * 8) * 72 + 4 * tq;
                u32x2 o;
                o.x = pk2(bf_lo(okp[0].x) * w0, bf_lo(okp[1].x) * w1); o.y = pk2(bf_lo(okp[2].x) * w2, bf_lo(okp[3].x) * w3); *(LAS u32x2*)(kp + 0 * 72) = o;
                o.x = pk2(bf_hi(okp[0].x) * w0, bf_hi(okp[1].x) * w1); o.y = pk2(bf_hi(okp[2].x) * w2, bf_hi(okp[3].x) * w3); *(LAS u32x2*)(kp + 1 * 72) = o;
                o.x = pk2(bf_lo(okp[0].y) * w0, bf_lo(okp[1].y) * w1); o.y = pk2(bf_lo(okp[2].y) * w2, bf_lo(okp[3].y) * w3); *(LAS u32x2*)(kp + 2 * 72) = o;
                o.x = pk2(bf_hi(okp[0].y) * w0, bf_hi(okp[1].y) * w1); o.y = pk2(bf_hi(okp[2].y) * w2, bf_hi(okp[3].y) * w3); *(LAS u32x2*)(kp + 3 * 72) = o;
                o.x = pk2(bf_lo(okp[0].z) * w0, bf_lo(okp[1].z) * w1); o.y = pk2(bf_lo(okp[2].z) * w2, bf_lo(okp[3].z) * w3); *(LAS u32x2*)(kp + 4 * 72) = o;
                o.x = pk2(bf_hi(okp[0].z) * w0, bf_hi(okp[1].z) * w1); o.y = pk2(bf_hi(okp[2].z) * w2, bf_hi(okp[3].z) * w3); *(LAS u32x2*)(kp + 5 * 72) = o;
                o.x = pk2(bf_lo(okp[0].w) * w0, bf_lo(okp[1].w) * w1); o.y = pk2(bf_lo(okp[2].w) * w2, bf_lo(okp[3].w) * w3); *(LAS u32x2*)(kp + 6 * 72) = o;
                o.x = pk2(bf_hi(okp[0].w) * w0, bf_hi(okp[1].w) * w1); o.y = pk2(bf_hi(okp[2].w) * w2, bf_hi(okp[3].w) * w3); *(LAS u32x2*)(kp + 7 * 72) = o;
            }
            LAS bf16_t* vp = Vt + (dcv * 8) * 72 + 2 * vt2;
            *(LAS unsigned*)(vp + 0 * 72) = (rv[0].x & 0xffffu) | (rv[1].x << 16); *(LAS unsigned*)(vp + 1 * 72) = (rv[0].x >> 16) | (rv[1].x & 0xffff0000u);
            *(LAS unsigned*)(vp + 2 * 72) = (rv[0].y & 0xffffu) | (rv[1].y << 16); *(LAS unsigned*)(vp + 3 * 72) = (rv[0].y >> 16) | (rv[1].y & 0xffff0000u);
            *(LAS unsigned*)(vp + 4 * 72) = (rv[0].z & 0xffffu) | (rv[1].z << 16); *(LAS unsigned*)(vp + 5 * 72) = (rv[0].z >> 16) | (rv[1].z & 0xffff0000u);
            *(LAS unsigned*)(vp + 6 * 72) = (rv[0].w & 0xffffu) | (rv[1].w << 16); *(LAS unsigned*)(vp + 7 * 72) = (rv[0].w >> 16) | (rv[1].w & 0xffff0000u);
        }
        u32x2 mo[4];
        bf16_t* orow = Z + (rowbase + t0 + tl) * LDZ + ZC_MO + h * 128 + half * 64 + fq * 4;
#pragma unroll
        for (int x = 0; x < 4; ++x) mo[x] = *(const u32x2*)(orow + x * 16);
        if (ch + 1 < SEQ / 64) ML_LOAD(ch + 1);
        __syncthreads();
        {   const int mt = w >> 1;
#pragma unroll
            for (int x = 0; x < 2; ++x) { const int nt = (w & 1) * 2 + x;
                f32x4 acc = (f32x4){0.f, 0.f, 0.f, 0.f};
#pragma unroll
                for (int ks = 0; ks < 4; ++ks) acc = MFMA16(frag(Qs, 136, mt * 16, ks * 32, lane), frag(Ks, 136, nt * 16, ks * 32, lane), acc);
                const int s = nt * 16 + fr; const float as = GA[s];
#pragma unroll
                for (int j = 0; j < 4; ++j) { const int t = mt * 16 + fq * 4 + j; const float pv = (s <= t) ? acc[j] * __expf(as - GM[t]) : 0.f; Ps[t * 72 + s] = f2bf(pv); }
            }
        }
        __syncthreads();
        {
            bf16x8 qfr[4], pfr[2];
#pragma unroll
            for (int ks = 0; ks < 4; ++ks) qfr[ks] = frag(Qs, 136, mt_t * 16, ks * 32, lane);
#pragma unroll
            for (int ks = 0; ks < 2; ++ks) pfr[ks] = frag(Ps, 72, mt_t * 16, ks * 32, lane);
            const float wi = WI[tl];
            f32x4 Hacc[5];
#pragma unroll
            for (int x = 0; x < 5; ++x) { const int me = (x < 4) ? half * 4 + x : 8;
                f32x4 acc = (f32x4){0.f, 0.f, 0.f, 0.f};
#pragma unroll
                for (int ks = 0; ks < 4; ++ks) acc = MFMA16(frag(Ct, 136, me * 16, ks * 32, lane), qfr[ks], acc);
                acc = acc * wi;
#pragma unroll
                for (int ks = 0; ks < 2; ++ks) acc = MFMA16(frag(Vt, 72, me * 16, ks * 32, lane), pfr[ks], acc);
                Hacc[x] = acc; }
            const float den = shidx(Hacc[4][0], fr);
            const float inv = 1.f / fmaxf(fabsf(den), EN[tl]);
            float s = 0.f;
#pragma unroll
            for (int x = 0; x < 4; ++x) { Hacc[x] = Hacc[x] * inv; s += (Hacc[x][0] * Hacc[x][0] + Hacc[x][1] * Hacc[x][1]) + (Hacc[x][2] * Hacc[x][2] + Hacc[x][3] * Hacc[x][3]); }
            s += shx(s, 16, lane); s += shx(s, 32, lane);
            if (fq == 0) SSQ[half * 64 + tl] = s;
            __syncthreads();
            const float r = frsq((SSQ[tl] + SSQ[64 + tl]) * (1.f / 128.f) + EPS);
#pragma unroll
            for (int x = 0; x < 4; ++x) { const f32x4 g4 = *(const LAS f32x4*)(MGs + half * 64 + x * 16 + fq * 4);
                u32x2 o;
                o.x = pk2(sigmoidf_(bf_lo(mo[x].x)) * Hacc[x][0] * r * g4[0], sigmoidf_(bf_hi(mo[x].x)) * Hacc[x][1] * r * g4[1]);
                o.y = pk2(sigmoidf_(bf_lo(mo[x].y)) * Hacc[x][2] * r * g4[2], sigmoidf_(bf_hi(mo[x].y)) * Hacc[x][3] * r * g4[3]);
                *(u32x2*)(orow + x * 16) = o; }
        }
        {   const float decay = SC[0];
#pragma unroll
            for (int nt = 0; nt < 9; ++nt) Cacc[nt] = Cacc[nt] * decay;
#pragma unroll
            for (int ks = 0; ks < 2; ++ks) { const bf16x8 af = frag(KWt, 72, w * 16, ks * 32, lane);
#pragma unroll
                for (int nt = 0; nt < 9; ++nt) Cacc[nt] = MFMA16(af, frag(Vt, 72, nt * 16, ks * 32, lane), Cacc[nt]); }
#pragma unroll
            for (int nt = 0; nt < 9; ++nt) { u32x2 o; o.x = pk2(Cacc[nt][0], Cacc[nt][1]); o.y = pk2(Cacc[nt][2], Cacc[nt][3]);
                *(LAS u32x2*)(Ct + (nt * 16 + fr) * 136 + w * 16 + fq * 4) = o; }
        }
        __syncthreads();
    }
#undef ML_LOAD
}

__device__ __forceinline__ void gmlp_item(LAS unsigned char* lds, bf16_t* Z, const float* gnorm, const float* gws, const float* gbs, int b, int sp, int tid) {
    asm volatile("" : "+v"(tid));
    const int lane = tid & 63, w = __builtin_amdgcn_readfirstlane(tid >> 6), fr = lane & 15, fq = lane >> 4;
    LAS bf16_t* As = (LAS bf16_t*)lds;
    LAS bf16_t* Vt = As + 128 * 136;
    LAS float* ST = (LAS float*)(Vt + 128 * 136);
    const size_t rowbase = (size_t)b * SEQ + sp * 128;
#pragma unroll 1
    for (int tb = 0; tb < 2; ++tb) {
        u32x4 rawv[8];
#pragma unroll
        for (int i = 0; i < 8; ++i) rawv[i] = *(const u32x4*)(Z + (rowbase + w * 16 + tb * 8 + i) * LDZ + ZC_GV + lane * 8);
        float s[8], q[8];
#pragma unroll
        for (int i = 0; i < 8; ++i) { const u32x4 raw = rawv[i];
            float x[8]; x[0] = bf_lo(raw.x); x[1] = bf_hi(raw.x); x[2] = bf_lo(raw.y); x[3] = bf_hi(raw.y); x[4] = bf_lo(raw.z); x[5] = bf_hi(raw.z); x[6] = bf_lo(raw.w); x[7] = bf_hi(raw.w);
            s[i] = 0.f; q[i] = 0.f;
#pragma unroll
            for (int e = 0; e < 8; ++e) { const float gx = gelu_tanh(x[e]); s[i] += gx; q[i] += gx * gx; } }
#pragma unroll
        for (int o = 1; o < 64; o <<= 1) {
#pragma unroll
            for (int i = 0; i < 8; ++i) { s[i] += shx(s[i], o, lane); q[i] += shx(q[i], o, lane); } }
        if (lane < 8) {
            float sv = s[0], qv = q[0];
#pragma unroll
            for (int i = 1; i < 8; ++i) { if (lane == i) { sv = s[i]; qv = q[i]; } }
            const float mean = sv * (1.f / 512.f); const float var = fmaxf(qv * (1.f / 512.f) - mean * mean, 0.f);
            const int t = w * 16 + tb * 8 + lane; ST[2 * t] = mean; ST[2 * t + 1] = frsq(var + EPS);
        }
    }
    __syncthreads();
#pragma unroll 1
    for (int g = 0; g < 4; ++g) {
        const float* wsg = gws + (size_t)g * 128 * 128; const float* bsg = gbs + g * 128;
#pragma unroll
        for (int i = 0; i < 8; ++i) { const int idx = tid + 512 * i; const int t = idx >> 5, s4 = (idx & 31) * 4;
            f32x4 wv = *(const f32x4*)(wsg + t * 128 + s4); if ((t >> 6) < (s4 >> 6)) wv = (f32x4){0.f, 0.f, 0.f, 0.f};
            u32x2 o; o.x = pk2(wv[0], wv[1]); o.y = pk2(wv[2], wv[3]); *(LAS u32x2*)(As + t * 136 + s4) = o; }
#pragma unroll
        for (int i = 0; i < 2; ++i) { const int u = tid + 512 * i; const int tp = u >> 4, dcg = u & 15;
            const bf16_t* src0 = Z + (rowbase + 2 * tp) * LDZ + ZC_GV + g * 128 + dcg * 8;
            const u32x4 ra = *(const u32x4*)src0, rb = *(const u32x4*)(src0 + LDZ);
            const float m0 = ST[4 * tp], r0 = ST[4 * tp + 1], m1 = ST[4 * tp + 2], r1 = ST[4 * tp + 3];
            const f32x4 g0 = *(const f32x4*)(gnorm + g * 128 + dcg * 8), g1 = *(const f32x4*)(gnorm + g * 128 + dcg * 8 + 4);
            LAS bf16_t* vp = Vt + (dcg * 8) * 136 + 2 * tp;
            *(LAS unsigned*)(vp + 0 * 136) = pk2((gelu_tanh(bf_lo(ra.x)) - m0) * r0 * g0[0], (gelu_tanh(bf_lo(rb.x)) - m1) * r1 * g0[0]);
            *(LAS unsigned*)(vp + 1 * 136) = pk2((gelu_tanh(bf_hi(ra.x)) - m0) * r0 * g0[1], (gelu_tanh(bf_hi(rb.x)) - m1) * r1 * g0[1]);
            *(LAS unsigned*)(vp + 2 * 136) = pk2((gelu_tanh(bf_lo(ra.y)) - m0) * r0 * g0[2], (gelu_tanh(bf_lo(rb.y)) - m1) * r1 * g0[2]);
            *(LAS unsigned*)(vp + 3 * 136) = pk2((gelu_tanh(bf_hi(ra.y)) - m0) * r0 * g0[3], (gelu_tanh(bf_hi(rb.y)) - m1) * r1 * g0[3]);
            *(LAS unsigned*)(vp + 4 * 136) = pk2((gelu_tanh(bf_lo(ra.z)) - m0) * r0 * g1[0], (gelu_tanh(bf_lo(rb.z)) - m1) * r1 * g1[0]);
            *(LAS unsigned*)(vp + 5 * 136) = pk2((gelu_tanh(bf_hi(ra.z)) - m0) * r0 * g1[1], (gelu_tanh(bf_hi(rb.z)) - m1) * r1 * g1[1]);
            *(LAS unsigned*)(vp + 6 * 136) = pk2((gelu_tanh(bf_lo(ra.w)) - m0) * r0 * g1[2], (gelu_tanh(bf_lo(rb.w)) - m1) * r1 * g1[2]);
            *(LAS unsigned*)(vp + 7 * 136) = pk2((gelu_tanh(bf_hi(ra.w)) - m0) * r0 * g1[3], (gelu_tanh(bf_hi(rb.w)) - m1) * r1 * g1[3]);
        }
        __syncthreads();
        f32x4 acc[8];
#pragma unroll
        for (int mt = 0; mt < 8; ++mt) acc[mt] = (f32x4){0.f, 0.f, 0.f, 0.f};
        const int kmax = (w < 4) ? 2 : 4;
        for (int ks = 0; ks < kmax; ++ks) { const bf16x8 bfr = frag(As, 136, w * 16, ks * 32, lane);
#pragma unroll
            for (int mt = 0; mt < 8; ++mt) acc[mt] = MFMA16(frag(Vt, 136, mt * 16, ks * 32, lane), bfr, acc[mt]); }
        {   const int t = w * 16 + fr; const float bt = bsg[t];
            bf16_t* rowp = Z + (rowbase + t) * LDZ + ZC_GU + g * 128 + fq * 4;
            u32x2 uu[8];
#pragma unroll
            for (int mt = 0; mt < 8; ++mt) uu[mt] = *(const u32x2*)(rowp + mt * 16);
#pragma unroll
            for (int mt = 0; mt < 8; ++mt) { u32x2 o;
                o.x = pk2(gelu_tanh(bf_lo(uu[mt].x)) * (acc[mt][0] + bt), gelu_tanh(bf_hi(uu[mt].x)) * (acc[mt][1] + bt));
                o.y = pk2(gelu_tanh(bf_lo(uu[mt].y)) * (acc[mt][2] + bt), gelu_tanh(bf_hi(uu[mt].y)) * (acc[mt][3] + bt));
                *(u32x2*)(rowp + mt * 16) = o; } }
        __syncthreads();
    }
}

__device__ __forceinline__ void xattn_item(LAS unsigned char* lds, const bf16_t* Q, const bf16_t* KB, const bf16_t* VT, bf16_t* Oo, int b, int h, int qb, int tid) {
    asm volatile("" : "+v"(tid));
    const int lane = tid & 63, w = __builtin_amdgcn_readfirstlane(tid >> 6), fr = lane & 15, fq = lane >> 4;
    LAS bf16_t* Ks = (LAS bf16_t*)lds;
    LAS bf16_t* Vt = Ks + 64 * 264;
    LAS bf16_t* Ps = Vt + 256 * 72 + w * 16 * 264;
    const size_t qrow = (size_t)b * SEQ + qb * 128 + w * 16;
    bf16x8 qf[8];
#pragma unroll
    for (int ks = 0; ks < 8; ++ks) qf[ks] = *(const bf16x8*)(Q + (qrow + fr) * D + h * 256 + ks * 32 + fq * 8);
    u32x4 pre[4];
    const bf16_t* kbase = KB + (size_t)(b * 256 + (tid >> 5)) * 1024 + h * 256 + (tid & 31) * 8;
    const bf16_t* vbase = VT + ((size_t)(b * 1024 + h * 256 + (tid >> 3))) * 256 + (tid & 7) * 8;
#pragma unroll
    for (int i = 0; i < 4; ++i) pre[i] = *(const u32x4*)(kbase + (size_t)(16 * i) * 1024);
    f32x4 S[16];
#pragma unroll
    for (int kc = 0; kc < 4; ++kc) {
        __syncthreads();
#pragma unroll
        for (int i = 0; i < 4; ++i) *(LAS u32x4*)(Ks + ((tid >> 5) + 16 * i) * 264 + (tid & 31) * 8) = pre[i];
        if (kc < 3) {
#pragma unroll
            for (int i = 0; i < 4; ++i) pre[i] = *(const u32x4*)(kbase + (size_t)((kc + 1) * 64 + 16 * i) * 1024);
        } else {
#pragma unroll
            for (int i = 0; i < 4; ++i) pre[i] = *(const u32x4*)(vbase + (size_t)(64 * i) * 256);
        }
        __syncthreads();
#pragma unroll
        for (int nt = 0; nt < 4; ++nt) { f32x4 acc = (f32x4){0.f, 0.f, 0.f, 0.f};
#pragma unroll
            for (int ks = 0; ks < 8; ++ks) acc = MFMA16(qf[ks], frag(Ks, 264, nt * 16, ks * 32, lane), acc);
            S[kc * 4 + nt] = acc; }
    }
    float inv[4];
#pragma unroll
    for (int j = 0; j < 4; ++j) {
        float mx = -INFINITY;
#pragma unroll
        for (int i = 0; i < 16; ++i) mx = fmaxf(mx, S[i][j]);
        mx = fmaxf(mx, shx(mx, 1, lane)); mx = fmaxf(mx, shx(mx, 2, lane)); mx = fmaxf(mx, shx(mx, 4, lane)); mx = fmaxf(mx, shx(mx, 8, lane));
        float sum = 0.f;
#pragma unroll
        for (int i = 0; i < 16; ++i) { const float p = __expf((S[i][j] - mx) * 0.0625f); sum += p; Ps[(fq * 4 + j) * 264 + i * 16 + fr] = f2bf(p); }
        sum += shx(sum, 1, lane); sum += shx(sum, 2, lane); sum += shx(sum, 4, lane); sum += shx(sum, 8, lane);
        inv[j] = 1.f / sum;
    }
    float invq;
    {   const int srcl = (fr >> 2) * 16;
        const float i0 = shidx(inv[0], srcl), i1 = shidx(inv[1], srcl), i2 = shidx(inv[2], srcl), i3 = shidx(inv[3], srcl);
        invq = (fr & 3) == 0 ? i0 : ((fr & 3) == 1 ? i1 : ((fr & 3) == 2 ? i2 : i3)); }
    f32x4 O[16];
#pragma unroll
    for (int nt = 0; nt < 16; ++nt) O[nt] = (f32x4){0.f, 0.f, 0.f, 0.f};
#pragma unroll
    for (int kc = 0; kc < 4; ++kc) {
        __syncthreads();
#pragma unroll
        for (int i = 0; i < 4; ++i) *(LAS u32x4*)(Vt + ((tid >> 3) + 64 * i) * 72 + (tid & 7) * 8) = pre[i];
        if (kc < 3) {
#pragma unroll
            for (int i = 0; i < 4; ++i) pre[i] = *(const u32x4*)(vbase + (size_t)(64 * i) * 256 + (kc + 1) * 64);
        }
        __syncthreads();
#pragma unroll
        for (int ks = 0; ks < 2; ++ks) { const bf16x8 pf = frag(Ps, 264, 0, kc * 64 + ks * 32, lane);
#pragma unroll
            for (int nt = 0; nt < 16; ++nt) O[nt] = MFMA16(frag(Vt, 72, nt * 16, ks * 32, lane), pf, O[nt]); }
    }
    bf16_t* op = Oo + (qrow + fr) * D + h * 256 + fq * 4;
#pragma unroll
    for (int nt = 0; nt < 16; ++nt) { u32x2 o; o.x = pk2(O[nt][0] * invq, O[nt][1] * invq); o.y = pk2(O[nt][2] * invq, O[nt][3] * invq); *(u32x2*)(op + nt * 16) = o; }
    __syncthreads();
}

#define XB_TMO      128
#define XB_XCNT(j)  (256  + 64 * (j))
#define XB_XSUB(j)  (1280 + 64 * (j))
#define XB_XGEN(j)  (2304 + 64 * (j))
#define XB_TOP      3328
#define XB_TOPGEN   3392
#define XCD_BAR_WORDS 3456
#define XB_SPIN_CAP (1u << 18)

__device__ __forceinline__ unsigned xb_ld(unsigned* p)              { return __hip_atomic_load(p, __ATOMIC_RELAXED, __HIP_MEMORY_SCOPE_AGENT); }
__device__ __forceinline__ unsigned xb_add(unsigned* p, unsigned v) { return __hip_atomic_fetch_add(p, v, __ATOMIC_RELAXED, __HIP_MEMORY_SCOPE_AGENT); }
__device__ __forceinline__ unsigned xb_xcc_id() { return (unsigned)__builtin_amdgcn_s_getreg((3 << 11) | 20) & 0xFu; }
#define XB_SPIN(cond, bar) do { unsigned _sp = 0; while (cond) { __builtin_amdgcn_s_sleep(1); \
    if ((++_sp & 255u) == 0u) { if (xb_ld(&(bar)[XB_TMO])) break; if (_sp > XB_SPIN_CAP) { atomicAdd(&(bar)[XB_TMO], 1u); break; } } } } while (0)

struct XcdBarrier {
    unsigned* bar; unsigned x;
    volatile LAS unsigned* st;
};

__device__ __forceinline__ XcdBarrier xcd_barrier_post(unsigned* bar, volatile LAS unsigned* st) {
    XcdBarrier b; b.bar = bar; b.x = xb_xcc_id(); b.st = st;
    if (threadIdx.x == 0) (void)xb_add(&bar[XB_XCNT(b.x)], 1u);
    return b;
}
__device__ __forceinline__ void xcd_barrier_complete(unsigned* bar, unsigned x, unsigned& nloc, unsigned& nx) {
    const unsigned G = gridDim.x * gridDim.y * gridDim.z;
    unsigned sum, cnt, mine, sp = 0u;
    for (;;) {
        sum = 0u; cnt = 0u; mine = 0u;
#pragma unroll
        for (unsigned j = 0; j < 16; ++j) { const unsigned c = xb_ld(&bar[XB_XCNT(j)]); sum += c; cnt += (c > 0u) ? 1u : 0u; mine = (j == x) ? c : mine; }
        if (sum == G) break;
        __builtin_amdgcn_s_sleep(1);
        if ((++sp & 255u) == 0u) { if (xb_ld(&bar[XB_TMO])) break; if (sp > XB_SPIN_CAP) { atomicAdd(&bar[XB_TMO], 1u); break; } }
    }
    nloc = mine > 0u ? mine : 1u; nx = cnt > 0u ? cnt : 1u;
}

__device__ __forceinline__ void xcd_barrier(const XcdBarrier& b) {
    asm volatile("s_waitcnt vmcnt(0)" ::: "memory");
    __syncthreads();
    if (threadIdx.x == 0) {
        unsigned* bar = b.bar;
        __builtin_amdgcn_s_waitcnt(0);
        unsigned nloc = b.st[0], nx = b.st[1];
        if (nloc == 0u) { xcd_barrier_complete(bar, b.x, nloc, nx); b.st[0] = nloc; b.st[1] = nx; }
        const unsigned old = xb_add(&bar[XB_XSUB(b.x)], 1u);
        const unsigned gen = old / nloc;
        if (old + 1u == (gen + 1u) * nloc) {
            __builtin_amdgcn_fence(__ATOMIC_RELEASE, "agent");
            asm volatile("s_waitcnt vmcnt(0)" ::: "memory");
            const unsigned og = xb_add(&bar[XB_TOP], 1u);
            const unsigned tg = og / nx;
            if (og + 1u == (tg + 1u) * nx) xb_add(&bar[XB_TOPGEN], 1u);
            else XB_SPIN(xb_ld(&bar[XB_TOPGEN]) == tg, bar);
            __builtin_amdgcn_fence(__ATOMIC_ACQUIRE, "agent");
            xb_add(&bar[XB_XGEN(b.x)], 1u);
            asm volatile("s_waitcnt vmcnt(0)" ::: "memory");
        } else {
            XB_SPIN(xb_ld(&bar[XB_XGEN(b.x)]) == gen, bar);
            __builtin_amdgcn_fence(__ATOMIC_ACQUIRE, "agent");
            asm volatile("s_waitcnt vmcnt(0)" ::: "memory");
        }
    }
    __syncthreads();
}


struct Args { const float* in[17]; float* out; unsigned char* ws; int ph_lo, ph_hi; };
__global__ void __launch_bounds__(512, 2) fwd_kernel(Args a) {
    extern __shared__ __attribute__((aligned(16))) unsigned char lds_raw[];
    LAS unsigned char* lds = (LAS unsigned char*)lds_raw;
    constexpr int G = 256; const int bx = blockIdx.x;
    cg::grid_group grid = cg::this_grid();
    {   volatile LAS unsigned* st0 = (volatile LAS unsigned*)(lds + LDS_BYTES - 32);
        if (threadIdx.x < 2) st0[threadIdx.x] = 0u;
        __syncthreads(); }
    const XcdBarrier xbar = xcd_barrier_post((unsigned*)(a.ws + WS_CTL) + 1024, (volatile LAS unsigned*)(lds + LDS_BYTES - 32));
    const int wave0 = __builtin_amdgcn_readfirstlane((int)threadIdx.x >> 6);
    for (int ph = a.ph_lo; ph < a.ph_hi; ++ph) {
    if (ph != a.ph_lo) { if (a.ph_hi < 0) grid.sync(); else xcd_barrier(xbar); }
    int tid; asm volatile("v_mbcnt_lo_u32_b32 %0, -1, 0\n\tv_mbcnt_hi_u32_b32 %0, -1, %0" : "=v"(tid)); tid += wave0 * 64;
    unsigned char* ws = a.ws;
    if (PROF_LO >= 0 && bx == 0 && tid == 0) {
        if (ph == PROF_LO && PROF_LO != 98) ((unsigned long long*)(ws + WS_CTL + 1024))[0] = __builtin_amdgcn_s_memrealtime();
        if (ph == PROF_HI && PROF_LO != 98) ((unsigned long long*)(ws + WS_CTL + 1024))[1] = __builtin_amdgcn_s_memrealtime();
    }
    const int lane = tid & 63, wave = __builtin_amdgcn_readfirstlane(tid >> 6);
    const int gw = bx * 8 + wave, NGW = G * 8, gtid = bx * 512 + tid, NGT = G * 512;
    bf16_t* ZH = (bf16_t*)(ws + WS_ZH); bf16_t* MRG = (bf16_t*)(ws + WS_MRG); bf16_t* KVb = (bf16_t*)(ws + WS_KV); bf16_t* MEMN = (bf16_t*)(ws + WS_MEMN);
    bf16_t* Y_A = ZH;
    bf16_t* H2A = (bf16_t*)(ws + WS_ZH + 64 * MiB);
    bf16_t* QB = (bf16_t*)(ws + WS_ZH + 128 * MiB);
    bf16_t* OB = (bf16_t*)(ws + WS_ZH + 192 * MiB);
    bf16_t* H2B = ZH;
    bf16_t* HID = (bf16_t*)(ws + WS_ZH + 64 * MiB);
    bf16_t* Win_t = (bf16_t*)(ws + WS_WIN); bf16_t* Wm_t = (bf16_t*)(ws + WS_WM); bf16_t* Wo_t = (bf16_t*)(ws + WS_WO); bf16_t* Wxq_t = (bf16_t*)(ws + WS_WXQ);
    bf16_t* Wxkv_t = (bf16_t*)(ws + WS_WXKV); bf16_t* Wxo_t = (bf16_t*)(ws + WS_WXO); bf16_t* W1_t = (bf16_t*)(ws + WS_W1); bf16_t* W2_t = (bf16_t*)(ws + WS_W2);
    const float* biasz = (const float*)(ws + WS_BIASZ);
    const float* x_in = a.in[0]; const float* mem = a.in[1]; const float* norms = a.in[2];
    float* xout = a.out;
    {
        if (ph == 0) {
            if (PROF_LO == 98) {
                if (bx == 0 && tid == 0) ((unsigned long long*)(ws + WS_CTL + 1024))[0] = __builtin_amdgcn_s_memrealtime();
                for (int i = 0; i < 16; ++i) xcd_barrier(xbar);
                if (bx == 0 && tid == 0) ((unsigned long long*)(ws + WS_CTL + 1024))[1] = __builtin_amdgcn_s_memrealtime();
            }
            LayerW L{a.in[3], a.in[4], a.in[10], a.in[11], a.in[12], a.in[13], a.in[14], a.in[15], a.in[16]};
            convert_weights(L, ws, lds, gw, NGW, wave, lane, gtid, NGT);
            norm_rows(x_in, nullptr, nullptr, nullptr, norms + 0 * D, ZH + HCOL, LDZ, MTOK, gw, NGW, lane);
            continue;
        }
        const int l = (ph - 1) / 12, k = (ph - 1) % 12 + 1;
        const float* gl = norms + (size_t)l * 7 * D;
        if (k == 1 || k == 4 || k == 6 || k == 8 || k == 10 || k == 11) {
            pg8::Gemm g; USched S; EpiStore E;
            S.G = G; S.c = bx; S.mode = 0; S.nM1 = 0; S.nN1 = 0; S.a1off = 0; S.b1off = 0; S.a0col = 0; S.nM0 = 128; S.nN0 = 4;
            E.O1 = nullptr; E.VT = nullptr; E.ldc1 = 0; E.bias = nullptr; E.act = 0; E.ldc0 = D;
            g.lda = D; g.K = D;
            if (k == 1) { g.A = ZH; g.Bt = Win_t; g.lda = LDZ; S.nN0 = 19; S.a0col = HCOL; E.O0 = ZH; E.ldc0 = LDZ; E.bias = biasz; }
            else if (k == 4) { g.A = MRG; g.Bt = Wo_t; E.O0 = Y_A; }
            else if (k == 6) { g.A = H2A; g.Bt = Wxq_t; S.mode = 1; S.nM1 = 16; S.nN1 = 8; S.a1off = (long)(MEMN - H2A); S.b1off = (long)(Wxkv_t - Wxq_t); E.O0 = QB; E.O1 = KVb; E.ldc1 = 1024; E.VT = KVb + (size_t)4096 * 1024; }
            else if (k == 8) { g.A = OB; g.Bt = Wxo_t; E.O0 = MRG; }
            else if (k == 10) { g.A = H2B; g.Bt = W1_t; S.nN0 = 16; E.O0 = HID; E.ldc0 = DFF; E.act = 2; }
            else { g.A = HID; g.Bt = W2_t; g.lda = DFF; g.K = DFF; E.O0 = MRG; }
            S.lda = g.lda; S.K = g.K;

#ifndef NO_GEMM
pg8::gemm_phase<EpiStore, USched, false>(lds, g, S, E, tid);
#endif

        } else if (k == 3) {
            pg8::Gemm g; g.A = ZH; g.Bt = Wm_t; g.lda = LDZ; g.K = D;
            USched S; S.G = G; S.c = bx; S.mode = 2; S.nM0 = 128; S.nN0 = 4; S.nM1 = 0; S.nN1 = 0; S.a1off = 0; S.b1off = 0; S.a0col = 0; S.lda = LDZ; S.K = D;
            EpiMerge E; E.Z = ZH; E.MRG = MRG; E.gbias = a.in[4] + (size_t)l * DIN + 4624;

#ifndef NO_MERGE
pg8::gemm_phase<EpiMerge, USched, true>(lds, g, S, E, tid);
#endif

        } else if (k == 2) {
            unsigned* ctr = (unsigned*)(ws + WS_CTL) + 64 * (l + 1);
            LAS int* qslot = (LAS int*)(lds + LDS_BYTES - 64);
            const float* convw = a.in[5] + (size_t)l * 4 * 1024; const float* mg = a.in[6] + (size_t)l * 512; const float* gnorm = a.in[7] + (size_t)l * 512;
            const float* gws = a.in[8] + (size_t)l * 4 * 128 * 128; const float* gbs = a.in[9] + (size_t)l * 4 * 128;
#define FETCH_ITEM() ({ __syncthreads(); if (tid == 0) *qslot = (int)atomicAdd(ctr, 1u); __syncthreads(); __builtin_amdgcn_readfirstlane(*qslot); })
            int it = FETCH_ITEM();
            while (it < 64) {
#ifndef NO_MLSTM
                mlstm_item(lds, ZH, convw, mg, it >> 2, it & 3, tid);
#endif
                if (PROF_HI == 97 && l == 0 && tid == 0) atomicMax((unsigned long long*)(ws + WS_CTL + 1024) + 1, (unsigned long long)__builtin_amdgcn_s_memrealtime());
                it = FETCH_ITEM();
            }
            while (it < 64 + 1024) {
                const int r = it - 64; const int bh = r >> 3, pp = 7 - (r & 7);
#ifndef NO_FOX
                fox_item(lds, ZH, bh >> 3, bh & 7, pp, tid);
#endif
                if (PROF_HI == 96 && l == 0 && tid == 0) atomicMax((unsigned long long*)(ws + WS_CTL + 1024) + 1, (unsigned long long)__builtin_amdgcn_s_memrealtime());
                it = FETCH_ITEM();
            }
            while (it < 64 + 1024 + 256) {
                const int r = it - 1088; const int sp = r & 15, bb = r >> 4;
#ifndef NO_GMLP
                gmlp_item(lds, ZH, gnorm, gws, gbs, bb, sp, tid);
#endif
                it = FETCH_ITEM();
            }
#undef FETCH_ITEM
        } else if (k == 7) {

#ifndef NO_XATTN
for (int it = bx; it < 1024; it += G) xattn_item(lds, QB, KVb, KVb + (size_t)4096 * 1024, OB, it >> 6, (it >> 4) & 3, it & 15, tid);
#endif

        } else if (k == 5) {
            norm_rows(l == 0 ? x_in : xout, xout, Y_A, gl + 1 * D, gl + 2 * D, H2A, D, MTOK, gw, NGW, lane);
            norm_rows(mem, nullptr, nullptr, nullptr, gl + 4 * D, MEMN, D, MEMR, gw, NGW, lane);
        } else if (k == 9) {
            norm_rows(xout, xout, MRG, gl + 3 * D, gl + 5 * D, H2B, D, MTOK, gw, NGW, lane);
        } else {
            if (l + 1 < DEPTH) {
                norm_rows(xout, xout, MRG, gl + 6 * D, norms + (size_t)(l + 1) * 7 * D, ZH + HCOL, LDZ, MTOK, gw, NGW, lane);
                const int n = l + 1;
                LayerW L{a.in[3] + (size_t)n * D * DIN, a.in[4] + (size_t)n * DIN, a.in[10] + (size_t)n * 3 * 512 * 1024, a.in[11] + (size_t)n * D * D, a.in[12] + (size_t)n * D * D,
                         a.in[13] + (size_t)n * D * 2 * D, a.in[14] + (size_t)n * D * D, a.in[15] + (size_t)n * D * DFF, a.in[16] + (size_t)n * DFF * D};
                convert_weights(L, ws, lds, gw, NGW, wave, lane, gtid, NGT);
            } else {
                norm_rows(xout, xout, MRG, gl + 6 * D, nullptr, nullptr, 0, MTOK, gw, NGW, lane);
                if (PROF_LO >= 0 && bx == 0) {
                    __syncthreads();
                    const unsigned long long* pt = (const unsigned long long*)(ws + WS_CTL + 1024);
                    long n = (PROF_LO == 99) ? 4000 : (long)((pt[1] - pt[0]) / 100ull);
                    if (n > 8192) n = 8192;
                    for (int i = tid; i < n; i += 512) xout[i] += 0.25f;
                }
            }
        }
    }
    }
}

extern "C" void kernel_launch(void* const* d_in, const int* in_sizes, int n_in, void* d_out, int out_size, void* d_ws, size_t ws_size, hipStream_t stream) {
    static int grid = 0;
    if (grid == 0) {
        if (n_in != 17 || ws_size < WS_END) { fprintf(stderr, "kernel_launch: unexpected n_in %d or ws_size %zu (< %zu)\n", n_in, ws_size, (size_t)WS_END); grid = -1; return; }
        int dev = 0, cus = 0, per_cu = 0;
        (void)hipGetDevice(&dev);
        (void)hipDeviceGetAttribute(&cus, hipDeviceAttributeMultiprocessorCount, dev);
        if (hipFuncSetAttribute((const void*)fwd_kernel, hipFuncAttributeMaxDynamicSharedMemorySize, LDS_BYTES) != hipSuccess) { fprintf(stderr, "kernel_launch: hipFuncSetAttribute failed\n"); }
        if (hipOccupancyMaxActiveBlocksPerMultiprocessor(&per_cu, (const void*)fwd_kernel, 512, LDS_BYTES) != hipSuccess || per_cu < 1) { fprintf(stderr, "kernel_launch: occupancy query says %d\n", per_cu); per_cu = 1; }
        (void)hipGetLastError();
        if (cus <= 0) cus = 256;
        if (cus < 256) fprintf(stderr, "kernel_launch: device reports %d CUs; this kernel is built for a 256-workgroup cooperative grid\n", cus);
        grid = 256;
    }
    if (grid < 0) return;
    (void)hipMemsetAsync((char*)d_ws + WS_CTL, 0, 32768, stream);
    Args a{};
    for (int i = 0; i < 17; ++i) a.in[i] = (const float*)d_in[i];
    a.out = (float*)d_out; a.ws = (unsigned char*)d_ws;
#if MK_MULTI
    for (int ph = 0; ph < NPHASE; ++ph) {
        a.ph_lo = ph; a.ph_hi = ph + 1;
        hipLaunchKernelGGL(fwd_kernel, dim3(grid), dim3(512), LDS_BYTES, stream, a);
    }
#else
    a.ph_lo = 0; a.ph_hi = NPHASE;
    void* args[] = {&a};
    hipError_t e = hipLaunchCooperativeKernel((const void*)fwd_kernel, dim3(grid), dim3(512), args, LDS_BYTES, stream);
    if (e != hipSuccess) fprintf(stderr, "cooperative launch failed: %s (grid %d)\n", hipGetErrorString(e), grid);
#endif
}
```

```cpp
#include <hip/hip_runtime.h>
#include <hip/hip_cooperative_groups.h>
#include <cstdio>
#include <cstdint>
namespace cg = cooperative_groups;

#ifndef MK_MULTI
#define MK_MULTI 0
#endif

#ifndef PROF_LO
#define PROF_LO -1
#define PROF_HI -1
#endif
#define LAS __attribute__((address_space(3)))
typedef unsigned short bf16_t;
typedef short bf16x8 __attribute__((ext_vector_type(8)));
typedef float f32x4 __attribute__((ext_vector_type(4)));
typedef unsigned u32x4 __attribute__((ext_vector_type(4)));
typedef unsigned u32x2 __attribute__((ext_vector_type(2)));
typedef float f32x2_t __attribute__((ext_vector_type(2)));
typedef __bf16 bf16x2_t __attribute__((ext_vector_type(2)));

namespace pg8 {
#define PG8_LAS __attribute__((address_space(3)))
constexpr int BM = 256, BK = 64, HALF = 128, HTB = HALF * BK * 2, STAGE_BYTES = 8 * HTB, NXCD = 8, WGM = 8;

__host__ __device__ __forceinline__ int lds_byte(int r, int c) { const int st = (r >> 4) * 2 + (c >> 5), rr = r & 15, cc = c & 31, ob = rr * 64 + cc * 2; return st * 1024 + (ob ^ (((ob >> 9) & 1) << 5)); }
__host__ __device__ __forceinline__ void stage_rc(int b, int& R, int& C) { const int st = b / 1024, sb = b % 1024, swz = sb ^ (((sb >> 9) & 1) << 5); R = (st >> 1) * 16 + swz / 64; C = (st & 1) * 32 + (swz % 64) / 2; }
__host__ __device__ __forceinline__ int perm32(int rho) { const int n = rho >> 4, i = rho & 15; return 8 * (i >> 2) + 4 * n + (i & 3); }

struct Unit { int pm, pn, sub, nt; long aoff, boff; };
struct Gemm { const bf16_t* A; const bf16_t* Bt; int lda, K; };

template <class Epi, class Sched, bool ALIGN_EPI>
__device__ __forceinline__ void gemm_phase(PG8_LAS unsigned char* lds, const Gemm g, const Sched& S, const Epi& E, int tid) {
    asm volatile("" : "+v"(tid));
    const int wid = __builtin_amdgcn_readfirstlane(tid >> 6), lane = tid & 63, wr = wid >> 2, wc = wid & 3, fr = lane & 15, fq = lane >> 4;
    const int K = g.K, lda = g.lda;
    unsigned voffA[2], voffB[2];
#pragma unroll
    for (int i = 0; i < 2; ++i) { int R, C; stage_rc(tid * 16 + i * 8192, R, C); const int Rb = Epi::PERM ? ((R & ~31) + perm32(R & 31)) : R;
        voffA[i] = (unsigned)(R * lda + C) * 2u; voffB[i] = (unsigned)(Rb * K + C) * 2u; }
    const size_t kstep = (size_t)(BK * 2);
    const size_t hstepA = (size_t)HALF * lda * 2, hstepB = (size_t)HALF * K * 2;
    const unsigned ldsw = (unsigned)wid * 1024u;
    const int aoff = lds_byte(wr * 64 + fr, fq * 8), boff = lds_byte(wc * 32 + fr, fq * 8);
#define PG8_SA(b, h) (((b) * 2 + (h)) * HTB)
#define PG8_SB(b, h) ((4 + (b) * 2 + (h)) * HTB)
#define PG8_STAGE(bufoff, gbase, voff) do { _Pragma("unroll") for (int _i = 0; _i < 2; ++_i) \
        __builtin_amdgcn_global_load_lds((const unsigned*)((const char*)(gbase) + (voff)[_i]), (PG8_LAS unsigned*)(lds + (bufoff) + ldsw + _i * 8192), 16, 0, 0); } while (0)
#define PG8_LDA(dst, b, h) do { _Pragma("unroll") for (int m = 0; m < 4; ++m) _Pragma("unroll") for (int k = 0; k < 2; ++k) dst[m][k] = *(const PG8_LAS bf16x8*)(lds + PG8_SA(b, h) + aoff + m * 2048 + k * 1024); } while (0)
#define PG8_LDB(dst, b, h) do { _Pragma("unroll") for (int n = 0; n < 2; ++n) _Pragma("unroll") for (int k = 0; k < 2; ++k) dst[n][k] = *(const PG8_LAS bf16x8*)(lds + PG8_SB(b, h) + boff + n * 2048 + k * 1024); } while (0)
#define PG8_MMA(ai, bj, At, Bt) do { __builtin_amdgcn_s_setprio(1); _Pragma("unroll") for (int m = 0; m < 4; ++m) _Pragma("unroll") for (int n = 0; n < 2; ++n) _Pragma("unroll") for (int k = 0; k < 2; ++k) \
        acc[ai][bj][m][n] = __builtin_amdgcn_mfma_f32_16x16x32_bf16(Bt[n][k], At[m][k], acc[ai][bj][m][n], 0, 0, 0); __builtin_amdgcn_s_setprio(0); } while (0)
#define PG8_WAIT_V(n) asm volatile("s_waitcnt vmcnt(" #n ")" ::: "memory")
#define PG8_WAIT_L(n) asm volatile("s_waitcnt lgkmcnt(" #n ")" ::: "memory")
#define PG8_BAR __builtin_amdgcn_s_barrier()
#define PG8_SCHED __builtin_amdgcn_sched_barrier(0)
    Unit cur, nxt; int ui = 0;
    if (!S.next(0, cur)) return;
    int nt = cur.nt;
    f32x4 acc[2][2][4][2];
#pragma unroll
    for (int a = 0; a < 2; ++a)
#pragma unroll
        for (int b = 0; b < 2; ++b)
#pragma unroll
            for (int m = 0; m < 4; ++m)
#pragma unroll
                for (int n = 0; n < 2; ++n) acc[a][b][m][n] = (f32x4){0.f, 0.f, 0.f, 0.f};
    bf16x8 At[4][2], B0[2][2], B1[2][2];
    const char* cA = (const char*)g.A + cur.aoff * 2; const char* cB = (const char*)g.Bt + cur.boff * 2;
    PG8_STAGE(PG8_SB(0, 0), cB, voffB); PG8_STAGE(PG8_SB(0, 1), cB + hstepB, voffB); PG8_STAGE(PG8_SA(0, 0), cA, voffA); PG8_STAGE(PG8_SA(0, 1), cA + hstepA, voffA);
    if (wr == 1) PG8_BAR;
    PG8_WAIT_V(2); PG8_BAR;
    PG8_STAGE(PG8_SB(1, 0), cB + kstep, voffB); PG8_STAGE(PG8_SA(1, 0), cA + kstep, voffA); PG8_STAGE(PG8_SB(1, 1), cB + hstepB + kstep, voffB);
    PG8_WAIT_V(6); PG8_BAR;
    for (;;) {
        const bool has_next = S.next(ui + 1, nxt);
        const char* nA = has_next ? (const char*)g.A + nxt.aoff * 2 : cA; const char* nB = has_next ? (const char*)g.Bt + nxt.boff * 2 : cB;
        for (int t = 0; t < nt; t += 2) {
            const bool last = (t == nt - 2);
            const char* a1 = cA + (size_t)(t + 1) * kstep;
            const char* a2 = last ? nA : cA + (size_t)(t + 2) * kstep; const char* b2 = last ? nB : cB + (size_t)(t + 2) * kstep;
            const char* a3 = a2 + kstep; const char* b3 = b2 + kstep;
            PG8_LDB(B0, 0, 0); PG8_LDB(B1, 0, 1); PG8_SCHED; PG8_LDA(At, 0, 0); PG8_STAGE(PG8_SA(1, 1), a1 + hstepA, voffA);
            PG8_WAIT_V(8); PG8_WAIT_L(0); PG8_BAR; PG8_MMA(0, 0, At, B0); PG8_MMA(0, 1, At, B1); PG8_BAR; PG8_SCHED;
            PG8_LDA(At, 0, 1); PG8_STAGE(PG8_SB(0, 0), b2, voffB); PG8_STAGE(PG8_SB(0, 1), b2 + hstepB, voffB); PG8_STAGE(PG8_SA(0, 0), a2, voffA);
            PG8_WAIT_V(8); PG8_WAIT_L(0); PG8_BAR; PG8_MMA(1, 0, At, B0); PG8_MMA(1, 1, At, B1); PG8_BAR; PG8_SCHED;
            PG8_LDB(B0, 1, 0); PG8_LDB(B1, 1, 1); PG8_SCHED; PG8_LDA(At, 1, 0); PG8_STAGE(PG8_SA(0, 1), a2 + hstepA, voffA);
            PG8_WAIT_V(8); PG8_WAIT_L(0); PG8_BAR; PG8_MMA(0, 0, At, B0); PG8_MMA(0, 1, At, B1); PG8_BAR; PG8_SCHED;
            PG8_LDA(At, 1, 1); PG8_STAGE(PG8_SB(1, 0), b3, voffB); PG8_STAGE(PG8_SB(1, 1), b3 + hstepB, voffB); PG8_STAGE(PG8_SA(1, 0), a3, voffA);
            PG8_WAIT_V(8); PG8_WAIT_L(0); PG8_BAR; PG8_MMA(1, 0, At, B0); PG8_MMA(1, 1, At, B1); PG8_BAR; PG8_SCHED;
        }
        if constexpr (ALIGN_EPI) { if (wr == 0) PG8_BAR; }
        E(acc, cur, wr, wc, fr, fq);
        if (!has_next) break;
#pragma unroll
        for (int a = 0; a < 2; ++a)
#pragma unroll
            for (int b = 0; b < 2; ++b)
#pragma unroll
                for (int m = 0; m < 4; ++m)
#pragma unroll
                    for (int n = 0; n < 2; ++n) acc[a][b][m][n] = (f32x4){0.f, 0.f, 0.f, 0.f};
        cur = nxt; cA = nA; cB = nB; ++ui; nt = cur.nt;
        if constexpr (ALIGN_EPI) { if (wr == 1) PG8_BAR; }
    }
    PG8_WAIT_V(0);
    if constexpr (!ALIGN_EPI) { if (wr == 0) PG8_BAR; }
    PG8_BAR;
#undef PG8_SA
#undef PG8_SB
#undef PG8_STAGE
#undef PG8_LDA
#undef PG8_LDB
#undef PG8_MMA
#undef PG8_WAIT_V
#undef PG8_WAIT_L
#undef PG8_BAR
#undef PG8_SCHED
}
}

constexpr int D = 1024, BATCH = 16, SEQ = 2048, MTOK = BATCH * SEQ, DEPTH = 2, MEMR = 16 * 256, DFF = 4096, DIN = 7696;
constexpr int LDZ = 5888, HCOL = 4864;
constexpr int ZC_FQ = 0, ZC_FK = 512, ZC_FV = 1024, ZC_MQ = 1536, ZC_MK = 2048, ZC_MV = 2560, ZC_MO = 3072, ZC_GU = 3584, ZC_GV = 4096, ZC_SM = 4608;
constexpr int ZC_SCR = 1024;
constexpr float EPS = 1e-6f;
constexpr int NPHASE = 25;
constexpr int LDS_BYTES = 147456;

constexpr size_t MiB = 1u << 20;
constexpr size_t WS_CTL = 0;
constexpr size_t WS_WIN = 1 * MiB;
constexpr size_t WS_WM = WS_WIN + (size_t)4864 * 1024 * 2;
constexpr size_t WS_WO = WS_WM + (size_t)6144 * 1024 * 2;
constexpr size_t WS_WXQ = WS_WO + 2 * MiB;
constexpr size_t WS_WXKV = WS_WXQ + 2 * MiB;
constexpr size_t WS_WXO = WS_WXKV + 4 * MiB;
constexpr size_t WS_W1 = WS_WXO + 2 * MiB;
constexpr size_t WS_W2 = WS_W1 + 8 * MiB;
constexpr size_t WS_BIASZ = WS_W2 + 8 * MiB;
constexpr size_t WS_KV = 50 * MiB;
constexpr size_t WS_MEMN = 66 * MiB;
constexpr size_t WS_ZH = 74 * MiB;
constexpr size_t WS_MRG = 442 * MiB;
constexpr size_t WS_END = 506 * MiB;
static_assert(WS_BIASZ + 4864 * 4 <= WS_KV, "ws map");

__device__ __forceinline__ float bf_lo(unsigned u) { return __uint_as_float(u << 16); }
__device__ __forceinline__ float bf_hi(unsigned u) { return __uint_as_float(u & 0xffff0000u); }
__device__ __forceinline__ float bf2f(bf16_t b) { return __uint_as_float(((unsigned)b) << 16); }
__device__ __forceinline__ unsigned pk2(float lo, float hi) { f32x2_t v = {lo, hi}; bf16x2_t b = __builtin_convertvector(v, bf16x2_t); return __builtin_bit_cast(unsigned, b); }
__device__ __forceinline__ bf16_t f2bf(float f) { return (bf16_t)(pk2(f, 0.f) & 0xffffu); }
__device__ __forceinline__ float shidx(float v, int src) { return __int_as_float(__builtin_amdgcn_ds_bpermute(src << 2, __float_as_int(v))); }
__device__ __forceinline__ float shx(float v, int m, int lane) { return shidx(v, lane ^ m); }
__device__ __forceinline__ float shup(float v, int o, int lane) { return shidx(v, (lane - o) & 63); }
__device__ __forceinline__ float wave_sum(float v, int lane) {
#pragma unroll
    for (int o = 1; o < 64; o <<= 1) v += shx(v, o, lane);
    return v;
}
__device__ __forceinline__ float frcp(float x) { return __builtin_amdgcn_rcpf(x); }
__device__ __forceinline__ float frsq(float x) { return __builtin_amdgcn_rsqf(x); }
__device__ __forceinline__ float sigmoidf_(float x) { return frcp(1.f + __expf(-x)); }
__device__ __forceinline__ float logsigmoidf_(float x) { return fminf(x, 0.f) - __logf(1.f + __expf(-fabsf(x))); }
__device__ __forceinline__ float gelu_tanh(float x) {
    const float a = fmaf(x * x, -0.10294324f, -2.3022082f); return x * frcp(1.f + __builtin_amdgcn_exp2f(x * a)); }
#define MFMA16(a, b, c) __builtin_amdgcn_mfma_f32_16x16x32_bf16((a), (b), (c), 0, 0, 0)
__device__ __forceinline__ bf16x8 frag(const LAS bf16_t* p, int ld, int row0, int k0, int lane) { return *(const LAS bf16x8*)(p + (row0 + (lane & 15)) * ld + k0 + (lane >> 4) * 8); }
#define LDS_FENCE() asm volatile("s_waitcnt lgkmcnt(0)" ::: "memory")

__device__ __forceinline__ void tile_map(int wgid, int nM, int nN, int& pm, int& pn) {
    const int nwg = nM * nN;
    { const int q = nwg / pg8::NXCD, r = nwg % pg8::NXCD, xcd = wgid % pg8::NXCD, off = wgid / pg8::NXCD; wgid = (xcd < r ? xcd * (q + 1) : r * (q + 1) + (xcd - r) * q) + off; }
    const int nig = pg8::WGM * nN, gid = wgid / nig, fm = gid * pg8::WGM, gsz = (nM - fm) < pg8::WGM ? (nM - fm) : pg8::WGM;
    pm = fm + ((wgid % nig) % gsz); pn = (wgid % nig) / gsz;
}
struct USched {
    int mode;
    int G, c, nM0, nN0, nM1, nN1;
    long lda, K, a0col, a1off, b1off;
    __device__ __forceinline__ bool next(int i, pg8::Unit& u) const {
        if (mode == 2) {
            const int ti = i / 6, s = i - ti * 6; const long L = (long)ti * G + c; if (L >= (long)nM0 * nN0) return false;
            int pm, pn; tile_map((int)L, nM0, nN0, pm, pn);
            const int n = s >> 1, br = s & 1;
            const long acol = br ? (n == 0 ? (long)ZC_FQ : (n == 1 ? (long)ZC_MO : (long)ZC_GU)) : (long)HCOL;
            u.pm = pm; u.pn = pn; u.sub = s; u.nt = br ? 8 : 16; u.aoff = (long)pm * 256 * lda + acol; u.boff = ((long)(br ? 3072 : 0) + n * 1024 + pn * 256) * K; return true;
        }
        const long L = (long)i * G + c; const long n0 = (long)nM0 * nN0;
        if (L < n0) { int pm, pn; tile_map((int)L, nM0, nN0, pm, pn); u.pm = pm; u.pn = pn; u.sub = 0; u.nt = (int)(K >> 6); u.aoff = (long)pm * 256 * lda + a0col; u.boff = (long)pn * 256 * K; return true; }
        if (mode == 1 && L < n0 + (long)nM1 * nN1) { int pm, pn; tile_map((int)(L - n0), nM1, nN1, pm, pn); u.pm = pm; u.pn = pn; u.sub = 1; u.nt = (int)(K >> 6); u.aoff = a1off + (long)pm * 256 * lda; u.boff = b1off + (long)pn * 256 * K; return true; }
        return false;
    }
};

struct EpiStore {
    static constexpr bool PERM = true;
    bf16_t* O0; bf16_t* O1; bf16_t* VT; int ldc0, ldc1, act; const float* bias;
    __device__ __forceinline__ void operator()(const f32x4 (&acc)[2][2][4][2], const pg8::Unit& u, int wr, int wc, int fr, int fq) const {
        bf16_t* base = u.sub ? O1 : O0; const int ldc = u.sub ? ldc1 : ldc0;
        const int row0 = u.pm * 256 + wr * 64 + fr, col0 = u.pn * 256 + wc * 32 + 8 * fq;
        if (u.sub && u.pn >= 4) {
#pragma unroll
            for (int ai = 0; ai < 2; ++ai)
#pragma unroll
                for (int m = 0; m < 4; ++m) { const int r = row0 + ai * 128 + m * 16; bf16_t* vp = VT + ((size_t)(r >> 8) * 1024 + (col0 - 1024)) * 256 + (r & 255);
#pragma unroll
                    for (int bj = 0; bj < 2; ++bj)
#pragma unroll
                        for (int n = 0; n < 2; ++n)
#pragma unroll
                            for (int e = 0; e < 4; ++e) vp[(size_t)(bj * 128 + n * 4 + e) * 256] = f2bf(acc[ai][bj][m][n][e]); }
            return;
        }
        f32x4 bv[2][2];
#pragma unroll
        for (int bj = 0; bj < 2; ++bj)
#pragma unroll
            for (int n = 0; n < 2; ++n) bv[bj][n] = bias ? *(const f32x4*)(bias + col0 + bj * 128 + 4 * n) : (f32x4){0.f, 0.f, 0.f, 0.f};
#pragma unroll
        for (int ai = 0; ai < 2; ++ai)
#pragma unroll
            for (int m = 0; m < 4; ++m) { bf16_t* rowp = base + (size_t)(row0 + ai * 128 + m * 16) * ldc + col0;
#pragma unroll
                for (int bj = 0; bj < 2; ++bj) { f32x4 v0 = acc[ai][bj][m][0] + bv[bj][0], v1 = acc[ai][bj][m][1] + bv[bj][1];
                    if (act == 2) {
#pragma unroll
                        for (int e = 0; e < 4; ++e) { const float a0 = fmaxf(v0[e], 0.f), a1 = fmaxf(v1[e], 0.f); v0[e] = a0 * a0; v1[e] = a1 * a1; } }
                    u32x4 w; w.x = pk2(v0[0], v0[1]); w.y = pk2(v0[2], v0[3]); w.z = pk2(v1[0], v1[1]); w.w = pk2(v1[2], v1[3]);
                    *(u32x4*)(rowp + bj * 128) = w; } }
    }
};
struct EpiMerge {
    static constexpr bool PERM = true, FUSED = false;
    bf16_t* Z; bf16_t* MRG; const float* gbias;
    __device__ __forceinline__ void operator()(const f32x4 (&acc)[2][2][4][2], const pg8::Unit& u, int wr, int wc, int fr, int fq) const {
        const int n = u.sub >> 1, br = u.sub & 1;
        const int row0 = u.pm * 256 + wr * 64 + fr, col0 = u.pn * 256 + wc * 32 + 8 * fq;
        if (!br) {
            f32x4 gb[2][2];
#pragma unroll
            for (int bj = 0; bj < 2; ++bj) { gb[bj][0] = *(const f32x4*)(gbias + n * 1024 + col0 + bj * 128); gb[bj][1] = *(const f32x4*)(gbias + n * 1024 + col0 + bj * 128 + 4); }
#pragma unroll
            for (int ai = 0; ai < 2; ++ai)
#pragma unroll
                for (int m = 0; m < 4; ++m) { bf16_t* sp = Z + (size_t)(row0 + ai * 128 + m * 16) * LDZ + ZC_SCR + col0;
#pragma unroll
                    for (int bj = 0; bj < 2; ++bj) { f32x4 v0 = acc[ai][bj][m][0], v1 = acc[ai][bj][m][1];
#pragma unroll
                        for (int e = 0; e < 4; ++e) { v0[e] = sigmoidf_(v0[e] + gb[bj][0][e]); v1[e] = sigmoidf_(v1[e] + gb[bj][1][e]); }
                        u32x4 w; w.x = pk2(v0[0], v0[1]); w.y = pk2(v0[2], v0[3]); w.z = pk2(v1[0], v1[1]); w.w = pk2(v1[2], v1[3]);
                        *(u32x4*)(sp + bj * 128) = w; } }
        } else {
#pragma unroll
            for (int ai = 0; ai < 2; ++ai) {
                u32x4 sv[4][2], qv[4][2];
#pragma unroll
                for (int m = 0; m < 4; ++m) { const size_t row = (size_t)(row0 + ai * 128 + m * 16);
#pragma unroll
                    for (int bj = 0; bj < 2; ++bj) { sv[m][bj] = *(const u32x4*)(Z + row * LDZ + ZC_SCR + col0 + bj * 128);
                        qv[m][bj] = (n > 0) ? *(const u32x4*)(MRG + row * D + col0 + bj * 128) : (u32x4){0u, 0u, 0u, 0u}; } }
#pragma unroll
                for (int m = 0; m < 4; ++m) { bf16_t* mp = MRG + (size_t)(row0 + ai * 128 + m * 16) * D + col0;
#pragma unroll
                    for (int bj = 0; bj < 2; ++bj) { f32x4 v0 = acc[ai][bj][m][0], v1 = acc[ai][bj][m][1]; const u32x4 s = sv[m][bj], q = qv[m][bj];
                        v0[0] = v0[0] * bf_lo(s.x) + bf_lo(q.x); v0[1] = v0[1] * bf_hi(s.x) + bf_hi(q.x); v0[2] = v0[2] * bf_lo(s.y) + bf_lo(q.y); v0[3] = v0[3] * bf_hi(s.y) + bf_hi(q.y);
                        v1[0] = v1[0] * bf_lo(s.z) + bf_lo(q.z); v1[1] = v1[1] * bf_hi(s.z) + bf_hi(q.z); v1[2] = v1[2] * bf_lo(s.w) + bf_lo(q.w); v1[3] = v1[3] * bf_hi(s.w) + bf_hi(q.w);
                        u32x4 w; w.x = pk2(v0[0], v0[1]); w.y = pk2(v0[2], v0[3]); w.z = pk2(v1[0], v1[1]); w.w = pk2(v1[2], v1[3]);
                        *(u32x4*)(mp + bj * 128) = w; } }
            }
        }
    }
};

__device__ __forceinline__ void norm_rows(const float* xsrc, float* xdst, const bf16_t* y, const float* gpost, const float* gpre, bf16_t* hout, int ldh, int nrows, int gw, int NGW, int lane) {
#pragma unroll 1
    for (int m = gw; m < nrows; m += 2 * NGW) {
        f32x4 v[2][4];
#pragma unroll
        for (int q = 0; q < 2; ++q) { const f32x4* xr = (const f32x4*)(xsrc + (size_t)(m + q * NGW) * D) + lane;
#pragma unroll
            for (int j = 0; j < 4; ++j) v[q][j] = xr[64 * j]; }
        if (y) {
            f32x4 yv[2][4]; float ss[2];
#pragma unroll
            for (int q = 0; q < 2; ++q) { const u32x2* yr = (const u32x2*)(y + (size_t)(m + q * NGW) * D) + lane; ss[q] = 0.f;
#pragma unroll
                for (int j = 0; j < 4; ++j) { const u32x2 t = yr[64 * j]; yv[q][j] = (f32x4){bf_lo(t.x), bf_hi(t.x), bf_lo(t.y), bf_hi(t.y)};
                    ss[q] += (yv[q][j][0] * yv[q][j][0] + yv[q][j][1] * yv[q][j][1]) + (yv[q][j][2] * yv[q][j][2] + yv[q][j][3] * yv[q][j][3]); } }
#pragma unroll
            for (int q = 0; q < 2; ++q) { const float r = frsq(wave_sum(ss[q], lane) * (1.f / D) + EPS);
                f32x4* xo = (f32x4*)(xdst + (size_t)(m + q * NGW) * D) + lane;
#pragma unroll
                for (int j = 0; j < 4; ++j) { const f32x4 gp = ((const f32x4*)gpost)[lane + 64 * j]; v[q][j] = v[q][j] + yv[q][j] * r * gp; xo[64 * j] = v[q][j]; } }
        }
        if (hout) {
#pragma unroll
            for (int q = 0; q < 2; ++q) { float ss = 0.f;
#pragma unroll
                for (int j = 0; j < 4; ++j) ss += (v[q][j][0] * v[q][j][0] + v[q][j][1] * v[q][j][1]) + (v[q][j][2] * v[q][j][2] + v[q][j][3] * v[q][j][3]);
                const float r = frsq(wave_sum(ss, lane) * (1.f / D) + EPS);
                u32x2* ho = (u32x2*)(hout + (size_t)(m + q * NGW) * ldh) + lane;
#pragma unroll
                for (int j = 0; j < 4; ++j) { const f32x4 gp = ((const f32x4*)gpre)[lane + 64 * j]; const f32x4 o = v[q][j] * r * gp; u32x2 w; w.x = pk2(o[0], o[1]); w.y = pk2(o[2], o[3]); ho[64 * j] = w; } }
        }
    }
}

__device__ __forceinline__ void tr_item(const float* W, int ldw, int col0, bf16_t* WT, int ldt, int row0, int nblk, LAS float* scr, int item, int lane) {
    const int kb = item / nblk, nb = item % nblk, k0 = 64 * kb, n0 = 32 * nb;
#pragma unroll
    for (int i = 0; i < 8; ++i) { const int kk = 8 * i + (lane >> 3); const f32x4 v = *(const f32x4*)(W + (size_t)(k0 + kk) * ldw + col0 + n0 + (lane & 7) * 4);
        LAS float* d = scr + kk * 33 + (lane & 7) * 4; d[0] = v[0]; d[1] = v[1]; d[2] = v[2]; d[3] = v[3]; }
    LDS_FENCE();
    const int c = lane & 7;
#pragma unroll
    for (int j = 0; j < 4; ++j) { const int n = (lane >> 3) + 8 * j; const LAS float* s = scr + (8 * c) * 33 + n;
        u32x4 o; o.x = pk2(s[0 * 33], s[1 * 33]); o.y = pk2(s[2 * 33], s[3 * 33]); o.z = pk2(s[4 * 33], s[5 * 33]); o.w = pk2(s[6 * 33], s[7 * 33]);
        *(u32x4*)(WT + (size_t)(row0 + n0 + n) * ldt + k0 + 8 * c) = o; }
    LDS_FENCE();
}
__device__ __forceinline__ int small_src(int i) { return i < 8 ? 1536 + i : (i < 12 ? 3080 + (i - 8) : 3084 + (i - 12)); }
struct LayerW { const float *w_in, *b_in, *w_branch, *w_out, *w_xq, *w_xkv, *w_xo, *w_ff1, *w_ff2; };
__device__ __forceinline__ void convert_weights(const LayerW& L, unsigned char* ws, LAS unsigned char* lds, int gw, int NGW, int wave, int lane, int gtid, int NGT) {
    bf16_t* Win_t = (bf16_t*)(ws + WS_WIN); bf16_t* Wm_t = (bf16_t*)(ws + WS_WM); bf16_t* Wo_t = (bf16_t*)(ws + WS_WO); bf16_t* Wxq_t = (bf16_t*)(ws + WS_WXQ);
    bf16_t* Wxkv_t = (bf16_t*)(ws + WS_WXKV); bf16_t* Wxo_t = (bf16_t*)(ws + WS_WXO); bf16_t* W1_t = (bf16_t*)(ws + WS_W1); bf16_t* W2_t = (bf16_t*)(ws + WS_W2);
    float* biasz = (float*)(ws + WS_BIASZ);
    LAS float* scr = (LAS float*)(lds + wave * 16384);
    constexpr int NIT = 768 + 768 + 256 + 512 + 1536 + 3 * 256 + 512 + 512 + 1024 + 512 + 2048 + 2048;
#pragma unroll 1
    for (int it = gw; it < NIT; it += NGW) {
        int r = it;
        if (r < 768) { tr_item(L.w_in, DIN, 0, Win_t, 1024, 0, 48, scr, r, lane); continue; } r -= 768;
        if (r < 768) { tr_item(L.w_in, DIN, 1544, Win_t, 1024, 1536, 48, scr, r, lane); continue; } r -= 768;
        if (r < 256) { tr_item(L.w_in, DIN, 3088, Win_t, 1024, 3072, 16, scr, r, lane); continue; } r -= 256;
        if (r < 512) { tr_item(L.w_in, DIN, 3600, Win_t, 1024, 3584, 32, scr, r, lane); continue; } r -= 512;
        if (r < 1536) { tr_item(L.w_in, DIN, 4624, Wm_t, 1024, 0, 96, scr, r, lane); continue; } r -= 1536;
        if (r < 768) { const int n = r >> 8; tr_item(L.w_branch + (size_t)n * 512 * 1024, 1024, 0, Wm_t, 1024, 3072 + n * 1024, 32, scr, r & 255, lane); continue; } r -= 768;
        if (r < 512) { tr_item(L.w_out, 1024, 0, Wo_t, 1024, 0, 32, scr, r, lane); continue; } r -= 512;
        if (r < 512) { tr_item(L.w_xq, 1024, 0, Wxq_t, 1024, 0, 32, scr, r, lane); continue; } r -= 512;
        if (r < 1024) { tr_item(L.w_xkv, 2048, 0, Wxkv_t, 1024, 0, 64, scr, r, lane); continue; } r -= 1024;
        if (r < 512) { tr_item(L.w_xo, 1024, 0, Wxo_t, 1024, 0, 32, scr, r, lane); continue; } r -= 512;
        if (r < 2048) { tr_item(L.w_ff1, 4096, 0, W1_t, 1024, 0, 128, scr, r, lane); continue; } r -= 2048;
        tr_item(L.w_ff2, 1024, 0, W2_t, 4096, 0, 32, scr, r, lane);
    }
    const u32x4 z4 = {0u, 0u, 0u, 0u};
#pragma unroll 1
    for (int i = gtid; i < 240 * 128; i += NGT) { const int row = i >> 7, c = i & 127; *(u32x4*)(Win_t + (size_t)(4624 + row) * 1024 + c * 8) = z4; }
#pragma unroll 1
    for (int i = gtid; i < 16 * 1024; i += NGT) { const int j = i >> 10, k = i & 1023; Win_t[(size_t)(4608 + j) * 1024 + k] = f2bf(L.w_in[(size_t)k * DIN + small_src(j)]); }
#pragma unroll 1
    for (int c = gtid; c < 4864; c += NGT) {
        float v;
        if (c < 1536) v = L.b_in[c]; else if (c < 3072) v = L.b_in[1544 + c - 1536]; else if (c < 3584) v = L.b_in[3088 + c - 3072];
        else if (c < 4608) v = L.b_in[3600 + c - 3584]; else if (c < 4624) v = L.b_in[small_src(c - 4608)]; else v = 0.f;
        biasz[c] = v;
    }
}

constexpr float L2E = 1.4426950408889634f;
__device__ __forceinline__ void fox_softmax(f32x4 (&S)[4], float FtL, int qrow, int kt, bool needmask, LAS bf16_t* Ps, int fr, int fq) {
    if (needmask) {
        const int t = qrow + fr;
#pragma unroll
        for (int nt = 0; nt < 4; ++nt)
#pragma unroll
            for (int j = 0; j < 4; ++j) { const int key = kt * 64 + nt * 16 + fq * 4 + j; if (key > t) S[nt][j] = -INFINITY; }
    }
#pragma unroll
    for (int nt = 0; nt < 4; ++nt) {
        const float p0 = __builtin_amdgcn_exp2f(fmaf(S[nt][0], L2E, FtL)), p1 = __builtin_amdgcn_exp2f(fmaf(S[nt][1], L2E, FtL));
        const float p2 = __builtin_amdgcn_exp2f(fmaf(S[nt][2], L2E, FtL)), p3 = __builtin_amdgcn_exp2f(fmaf(S[nt][3], L2E, FtL));
        u32x2 o; o.x = pk2(p0, p1); o.y = pk2(p2, p3);
        *(LAS u32x2*)(Ps + fr * 72 + nt * 16 + fq * 4) = o; }
}
template <bool BOTH>
__device__ __forceinline__ void fox_tile(const LAS bf16_t* Kb, const LAS bf16_t* Vb, const LAS float* NFk, const bf16x8 (&qfA)[2], const bf16x8 (&qfB)[2], float FtLA, float FtLB,
                                         f32x4 (&OA)[5], f32x4 (&OB)[5], int qrowA, int qrowB, int kt, LAS bf16_t* PsA, LAS bf16_t* PsB, int lane, int fr, int fq) {
    f32x4 SA[4], SB[4];
#pragma unroll
    for (int nt = 0; nt < 4; ++nt) { const bf16x8 k0 = frag(Kb, 72, nt * 16, 0, lane), k1 = frag(Kb, 72, nt * 16, 32, lane);
        const f32x4 nf = *(const LAS f32x4*)(NFk + nt * 16 + fq * 4);
        SB[nt] = MFMA16(k0, qfB[0], nf); SB[nt] = MFMA16(k1, qfB[1], SB[nt]);
        if constexpr (BOTH) { SA[nt] = MFMA16(k0, qfA[0], nf); SA[nt] = MFMA16(k1, qfA[1], SA[nt]); } }
    fox_softmax(SB, FtLB, qrowB, kt, kt * 64 + 63 > qrowB, PsB, fr, fq);
    if constexpr (BOTH) fox_softmax(SA, FtLA, qrowA, kt, kt * 64 + 63 > qrowA, PsA, fr, fq);
    LDS_FENCE();
#pragma unroll
    for (int ks = 0; ks < 2; ++ks) { const bf16x8 pB = frag(PsB, 72, 0, ks * 32, lane); bf16x8 pA = pB; if constexpr (BOTH) pA = frag(PsA, 72, 0, ks * 32, lane);
#pragma unroll
        for (int nt = 0; nt < 5; ++nt) { const bf16x8 vf = frag(Vb, 72, nt * 16, ks * 32, lane);
            OB[nt] = MFMA16(vf, pB, OB[nt]); if constexpr (BOTH) OA[nt] = MFMA16(vf, pA, OA[nt]); } }
    LDS_FENCE();
}
__device__ __forceinline__ bf16x8 scale_q(u32x4 r) {
    r.x = pk2(bf_lo(r.x) * 0.125f, bf_hi(r.x) * 0.125f); r.y = pk2(bf_lo(r.y) * 0.125f, bf_hi(r.y) * 0.125f);
    r.z = pk2(bf_lo(r.z) * 0.125f, bf_hi(r.z) * 0.125f); r.w = pk2(bf_lo(r.w) * 0.125f, bf_hi(r.w) * 0.125f);
    return __builtin_bit_cast(bf16x8, r);
}
__device__ __forceinline__ void fox_item(LAS unsigned char* lds, bf16_t* Z, int b, int h, int p, int tid) {
    asm volatile("" : "+v"(tid));
    const int lane = tid & 63, w = __builtin_amdgcn_readfirstlane(tid >> 6), fr = lane & 15, fq = lane >> 4;
    LAS float* NF = (LAS float*)lds;
    LAS float* wsum = (LAS float*)(lds + 8192);
    LAS bf16_t* Ks = (LAS bf16_t*)(lds + 8448);
    LAS bf16_t* Vt = Ks + 2 * 64 * 72;
    LAS bf16_t* PsA = Vt + 2 * 80 * 72 + w * 32 * 72;
    LAS bf16_t* PsB = PsA + 16 * 72;
    const int qbA = 2 * p, qbB = 2 * p + 1, q1 = (qbB + 1) * 128;
    const size_t rowbase = (size_t)b * SEQ;
    const int qrowA = qbA * 128 + w * 16, qrowB = qbB * 128 + w * 16;
    u32x4 qraw[4];
#pragma unroll
    for (int ks = 0; ks < 2; ++ks) { qraw[ks] = *(const u32x4*)(Z + (rowbase + qrowA + fr) * LDZ + ZC_FQ + h * 64 + ks * 32 + fq * 8);
                                     qraw[2 + ks] = *(const u32x4*)(Z + (rowbase + qrowB + fr) * LDZ + ZC_FQ + h * 64 + ks * 32 + fq * 8); }
    const bool vrole = tid < 256;
    const int su = tid & 255, skey = su >> 3, sdc = su & 7;
    const bf16_t* sbase = Z + rowbase * LDZ + h * 64 + sdc * 8 + (vrole ? (size_t)ZC_FV + (size_t)(2 * skey) * LDZ : (size_t)ZC_FK + (size_t)skey * LDZ);
    const size_t sstep = vrole ? (size_t)LDZ : (size_t)32 * LDZ;
    u32x4 r0, r1;
#define FOX_LOAD(kt_) do { const bf16_t* s_ = sbase + (size_t)(kt_) * 64 * LDZ; r0 = *(const u32x4*)s_; r1 = *(const u32x4*)(s_ + sstep); } while (0)
    FOX_LOAD(0);
    {
        float lf[4]; float run = 0.f;
#pragma unroll
        for (int i = 0; i < 4; ++i) { const int t = 4 * tid + i; float v = 0.f; if (t < q1) v = logsigmoidf_(bf2f(Z[(rowbase + t) * LDZ + ZC_SM + h])); run += v; lf[i] = run; }
        float sc = run;
#pragma unroll
        for (int o = 1; o < 64; o <<= 1) { const float nb = shup(sc, o, lane); if (lane >= o) sc += nb; }
        if (lane == 63) wsum[w] = sc;
        for (int i = tid; i < 2 * 16 * 72; i += 512) { const int bufi = i / (16 * 72), r = i % (16 * 72); Vt[bufi * 80 * 72 + 64 * 72 + r] = (r < 72) ? (bf16_t)0x3F80 : (bf16_t)0; }
        __syncthreads();
        float base = 0.f;
        for (int i = 0; i < w; ++i) base += wsum[i];
        const float excl = base + sc - run;
#pragma unroll
        for (int i = 0; i < 4; ++i) NF[4 * tid + i] = -(excl + lf[i]);
    }
    bf16x8 qfA[2], qfB[2];
#pragma unroll
    for (int ks = 0; ks < 2; ++ks) { qfA[ks] = scale_q(qraw[ks]); qfB[ks] = scale_q(qraw[2 + ks]); }
#define FOX_STORE(buf_) do { if (vrole) { LAS bf16_t* vp = Vt + (buf_) * 80 * 72 + (sdc * 8) * 72 + 2 * skey; \
        *(LAS unsigned*)(vp + 0 * 72) = (r0.x & 0xffffu) | (r1.x << 16); *(LAS unsigned*)(vp + 1 * 72) = (r0.x >> 16) | (r1.x & 0xffff0000u); \
        *(LAS unsigned*)(vp + 2 * 72) = (r0.y & 0xffffu) | (r1.y << 16); *(LAS unsigned*)(vp + 3 * 72) = (r0.y >> 16) | (r1.y & 0xffff0000u); \
        *(LAS unsigned*)(vp + 4 * 72) = (r0.z & 0xffffu) | (r1.z << 16); *(LAS unsigned*)(vp + 5 * 72) = (r0.z >> 16) | (r1.z & 0xffff0000u); \
        *(LAS unsigned*)(vp + 6 * 72) = (r0.w & 0xffffu) | (r1.w << 16); *(LAS unsigned*)(vp + 7 * 72) = (r0.w >> 16) | (r1.w & 0xffff0000u); } \
      else { *(LAS u32x4*)(Ks + (buf_) * 64 * 72 + skey * 72 + sdc * 8) = r0; *(LAS u32x4*)(Ks + (buf_) * 64 * 72 + (skey + 32) * 72 + sdc * 8) = r1; } } while (0)
    const int nkt = q1 / 64;
    FOX_STORE(0); FOX_LOAD(1);
    __syncthreads();
    const float FtLA = -NF[qrowA + fr] * L2E, FtLB = -NF[qrowB + fr] * L2E;
    f32x4 OA[5], OB[5];
#pragma unroll
    for (int nt = 0; nt < 5; ++nt) { OA[nt] = (f32x4){0.f, 0.f, 0.f, 0.f}; OB[nt] = (f32x4){0.f, 0.f, 0.f, 0.f}; }
    for (int kt = 0; kt < nkt; ++kt) {
        const int buf = kt & 1;
        if (kt + 1 < nkt) { FOX_STORE(buf ^ 1); if (kt + 2 < nkt) FOX_LOAD(kt + 2); }
        const bool actB = kt * 64 <= qrowB + 15, actA = kt * 64 <= qrowA + 15;
        if (actB) {
            const LAS bf16_t* Kb = Ks + buf * 64 * 72; const LAS bf16_t* Vb = Vt + buf * 80 * 72;
            if (actA) fox_tile<true>(Kb, Vb, NF + kt * 64, qfA, qfB, FtLA, FtLB, OA, OB, qrowA, qrowB, kt, PsA, PsB, lane, fr, fq);
            else fox_tile<false>(Kb, Vb, NF + kt * 64, qfA, qfB, FtLA, FtLB, OA, OB, qrowA, qrowB, kt, PsA, PsB, lane, fr, fq);
        }
        __syncthreads();
    }
#undef FOX_LOAD
#undef FOX_STORE
    {
        const float iA = 1.f / shidx(OA[4][0], fr), iB = 1.f / shidx(OB[4][0], fr);
        bf16_t* pa = Z + (rowbase + qrowA + fr) * LDZ + ZC_FQ + h * 64 + fq * 4; bf16_t* pb = Z + (rowbase + qrowB + fr) * LDZ + ZC_FQ + h * 64 + fq * 4;
#pragma unroll
        for (int nt = 0; nt < 4; ++nt) { u32x2 o;
            o.x = pk2(OA[nt][0] * iA, OA[nt][1] * iA); o.y = pk2(OA[nt][2] * iA, OA[nt][3] * iA); *(u32x2*)(pa + nt * 16) = o;
            o.x = pk2(OB[nt][0] * iB, OB[nt][1] * iB); o.y = pk2(OB[nt][2] * iB, OB[nt][3] * iB); *(u32x2*)(pb + nt * 16) = o; } }
    __syncthreads();
}

__device__ __forceinline__ void mlstm_item(LAS unsigned char* lds, bf16_t* Z, const float* convw, const float* mg, int b, int h, int tid) {
    asm volatile("" : "+v"(tid));
    const int lane = tid & 63, w = __builtin_amdgcn_readfirstlane(tid >> 6), fr = lane & 15, fq = lane >> 4;
    LAS bf16_t* Qs = (LAS bf16_t*)lds;
    LAS bf16_t* Ks = Qs + 64 * 136;
    LAS bf16_t* KWt = Ks + 64 * 136;
    LAS bf16_t* Vt = KWt + 128 * 72;
    LAS bf16_t* Ct = Vt + 144 * 72;
    LAS bf16_t* Ps = Ct + 144 * 136;
    LAS float* GA = (LAS float*)(Ps + 64 * 72);
    LAS float* GM = GA + 64; LAS float* WI = GA + 128; LAS float* EN = GA + 192; LAS float* WS = GA + 256; LAS float* SC = GA + 320;
    LAS float* SSQ = GA + 336;
    LAS float* CW = GA + 464;
    LAS float* MGs = GA + 1488;
    const size_t rowbase = (size_t)b * SEQ;
    for (int i = tid; i < 144 * 136 / 2; i += 512) ((LAS unsigned*)Ct)[i] = 0u;
    for (int i = tid; i < 16 * 72; i += 512) Vt[128 * 72 + i] = (i < 72) ? (bf16_t)0x3F80 : (bf16_t)0;
    for (int i = tid; i < 1024; i += 512) { const int j = i >> 8, c = i & 255; CW[i] = convw[j * 1024 + (c < 128 ? h * 128 + c : 512 + h * 128 + (c - 128))]; }
    if (tid < 128) MGs[tid] = mg[h * 128 + tid];
    f32x4 Cacc[9];
#pragma unroll
    for (int nt = 0; nt < 9; ++nt) Cacc[nt] = (f32x4){0.f, 0.f, 0.f, 0.f};
    float mprev = 0.f;
    const int role = __builtin_amdgcn_readfirstlane(tid >> 8);
    const int su = tid & 255, tq = su >> 4, dc = su & 15;
    const int vt2 = tid >> 4, dcv = tid & 15;
    const int mt_t = w & 3, half = w >> 2, tl = mt_t * 16 + fr;
    const bf16_t* qkbase = Z + rowbase * LDZ + (role ? ZC_MK : ZC_MQ) + h * 128 + dc * 8;
    const bf16_t* vbase = Z + (rowbase + 2 * vt2) * LDZ + ZC_MV + h * 128 + dcv * 8;
    u32x4 rq[7], rv[2]; float gi = 0.f, gf = 0.f;
#define ML_LOAD(ch_) do { const int t0_ = (ch_) * 64; \
        _Pragma("unroll") for (int i = 0; i < 7; ++i) { const int tg = t0_ + 4 * tq - 3 + i; rq[i] = (u32x4){0u, 0u, 0u, 0u}; if (tg >= 0) rq[i] = *(const u32x4*)(qkbase + (size_t)tg * LDZ); } \
        rv[0] = *(const u32x4*)(vbase + (size_t)t0_ * LDZ); rv[1] = *(const u32x4*)(vbase + (size_t)(t0_ + 1) * LDZ); \
        if (w == 0) { const size_t row = rowbase + t0_ + lane; gi = bf2f(Z[row * LDZ + ZC_SM + 8 + h]); gf = bf2f(Z[row * LDZ + ZC_SM + 12 + h]); } } while (0)
    ML_LOAD(0);
    for (int ch = 0; ch < SEQ / 64; ++ch) {
        const int t0 = ch * 64;
        if (w == 0) {
            float bc = logsigmoidf_(gf);
#pragma unroll
            for (int o = 1; o < 64; o <<= 1) { const float nb = shup(bc, o, lane); if (lane >= o) bc += nb; }
            const float av = gi - bc;
            float gm = av;
#pragma unroll
            for (int o = 1; o < 64; o <<= 1) { const float nb = shup(gm, o, lane); if (lane >= o) gm = fmaxf(gm, nb); }
            const float mm = fmaxf(mprev, gm), mt = bc + mm;
            GA[lane] = av; GM[lane] = mm; WI[lane] = __expf(mprev - mm); EN[lane] = __expf(-mt);
            const float mm63 = shidx(mm, 63), b63 = shidx(bc, 63);
            WS[lane] = __expf(av - mm63);
            if (lane == 0) SC[0] = __expf(mprev - mm63);
            mprev = b63 + mm63;
        }
        __syncthreads();
        {
            u32x4 okp[4];
#pragma unroll
            for (int a = 0; a < 4; ++a) {
                float acc[8];
#pragma unroll
                for (int e = 0; e < 8; ++e) acc[e] = 0.f;
#pragma unroll
                for (int j = 0; j < 4; ++j) { const u32x4 r = rq[a + j];
                    const f32x4 c0 = *(const LAS f32x4*)(CW + j * 256 + role * 128 + dc * 8), c1 = *(const LAS f32x4*)(CW + j * 256 + role * 128 + dc * 8 + 4);
                    acc[0] += c0[0] * bf_lo(r.x); acc[1] += c0[1] * bf_hi(r.x); acc[2] += c0[2] * bf_lo(r.y); acc[3] += c0[3] * bf_hi(r.y);
                    acc[4] += c1[0] * bf_lo(r.z); acc[5] += c1[1] * bf_hi(r.z); acc[6] += c1[2] * bf_lo(r.w); acc[7] += c1[3] * bf_hi(r.w); }
                const float sc_ = role ? 0.08838834764831845f : 1.f;
#pragma unroll
                for (int e = 0; e < 8; ++e) acc[e] = acc[e] * sigmoidf_(acc[e]) * sc_;
                u32x4 o; o.x = pk2(acc[0], acc[1]); o.y = pk2(acc[2], acc[3]); o.z = pk2(acc[4], acc[5]); o.w = pk2(acc[6], acc[7]);
                *(LAS u32x4*)((role ? Ks : Qs) + (4 * tq + a) * 136 + dc * 8) = o;
                okp[a] = o;
                asm volatile("" ::: "memory");
            }
            if (role == 1) {
                const float w0 = WS[4 * tq], w1 = WS[4 * tq + 1], w2 = WS[4 * tq + 2], w3 = WS[4 * tq + 3];
                LAS bf16_t* kp = KWt + (dc * 8) * 72 + 4 * tq;
                u32x2 o;
                o.x = pk2(bf_lo(okp[0].x) * w0, bf_lo(okp[1].x) * w1); o.y = pk2(bf_lo(okp[2].x) * w2, bf_lo(okp[3].x) * w3); *(LAS u32x2*)(kp + 0 * 72) = o;
                o.x = pk2(bf_hi(okp[0].x) * w0, bf_hi(okp[1].x) * w1); o.y = pk2(bf_hi(okp[2].x) * w2, bf_hi(okp[3].x) * w3); *(LAS u32x2*)(kp + 1 * 72) = o;
                o.x = pk2(bf_lo(okp[0].y) * w0, bf_lo(okp[1].y) * w1); o.y = pk2(bf_lo(okp[2].y) * w2, bf_lo(okp[3].y) * w3); *(LAS u32x2*)(kp + 2 * 72) = o;
                o.x = pk2(bf_hi(okp[0].y) * w0, bf_hi(okp[1].y) * w1); o.y = pk2(bf_hi(okp[2].y) * w2, bf_hi(okp[3].y) * w3); *(LAS u32x2*)(kp + 3 * 72) = o;
                o.x = pk2(bf_lo(okp[0].z) * w0, bf_lo(okp[1].z) * w1); o.y = pk2(bf_lo(okp[2].z) * w2, bf_lo(okp[3].z) * w3); *(LAS u32x2*)(kp + 4 * 72) = o;
                o.x = pk2(bf_hi(okp[0].z) * w0, bf_hi(okp[1].z) * w1); o.y = pk2(bf_hi(okp[2].z) * w2, bf_hi(okp[3].z) * w3); *(LAS u32x2*)(kp + 5 * 72) = o;
                o.x = pk2(bf_lo(okp[0].w) * w0, bf_lo(okp[1].w) * w1); o.y = pk2(bf_lo(okp[2].w) * w2, bf_lo(okp[3].w) * w3); *(LAS u32x2*)(kp + 6 * 72) = o;
                o.x = pk2(bf_hi(okp[0].w) * w0, bf_hi(okp[1].w) * w1); o.y = pk2(bf_hi(okp[2].w) * w2, bf_hi(okp[3].w) * w3); *(LAS u32x2*)(kp + 7 * 72) = o;
            }
            LAS bf16_t* vp = Vt + (dcv * 8) * 72 + 2 * vt2;
            *(LAS unsigned*)(vp + 0 * 72) = (rv[0].x & 0xffffu) | (rv[1].x << 16); *(LAS unsigned*)(vp + 1 * 72) = (rv[0].x >> 16) | (rv[1].x & 0xffff0000u);
            *(LAS unsigned*)(vp + 2 * 72) = (rv[0].y & 0xffffu) | (rv[1].y << 16); *(LAS unsigned*)(vp + 3 * 72) = (rv[0].y >> 16) | (rv[1].y & 0xffff0000u);
            *(LAS unsigned*)(vp + 4 * 72) = (rv[0].z & 0xffffu) | (rv[1].z << 16); *(LAS unsigned*)(vp + 5 * 72) = (rv[0].z >> 16) | (rv[1].z & 0xffff0000u);
            *(LAS unsigned*)(vp + 6 * 72) = (rv[0].w & 0xffffu) | (rv[1].w << 16); *(LAS unsigned*)(vp + 7 * 72) = (rv[0].w >> 16) | (rv[1].w & 0xffff0000u);
        }
        u32x2 mo[4];
        bf16_t* orow = Z + (rowbase + t0 + tl) * LDZ + ZC_MO + h * 128 + half * 64 + fq * 4;
#pragma unroll
        for (int x = 0; x < 4; ++x) mo[x] = *(const u32x2*)(orow + x * 16);
        if (ch + 1 < SEQ / 64) ML_LOAD(ch + 1);
        __syncthreads();
        {   const int mt = w >> 1;
#pragma unroll
            for (int x = 0; x < 2; ++x) { const int nt = (w & 1) * 2 + x;
                f32x4 acc = (f32x4){0.f, 0.f, 0.f, 0.f};
#pragma unroll
                for (int ks = 0; ks < 4; ++ks) acc = MFMA16(frag(Qs, 136, mt * 16, ks * 32, lane), frag(Ks, 136, nt * 16, ks * 32, lane), acc);
                const int s = nt * 16 + fr; const float as = GA[s];
#pragma unroll
                for (int j = 0; j < 4; ++j) { const int t = mt * 16 + fq * 4 + j; const float pv = (s <= t) ? acc[j] * __expf(as - GM[t]) : 0.f; Ps[t * 72 + s] = f2bf(pv); }
            }
        }
        __syncthreads();
        {
            bf16x8 qfr[4], pfr[2];
#pragma unroll
            for (int ks = 0; ks < 4; ++ks) qfr[ks] = frag(Qs, 136, mt_t * 16, ks * 32, lane);
#pragma unroll
            for (int ks = 0; ks < 2; ++ks) pfr[ks] = frag(Ps, 72, mt_t * 16, ks * 32, lane);
            const float wi = WI[tl];
            f32x4 Hacc[5];
#pragma unroll
            for (int x = 0; x < 5; ++x) { const int me = (x < 4) ? half * 4 + x : 8;
                f32x4 acc = (f32x4){0.f, 0.f, 0.f, 0.f};
#pragma unroll
                for (int ks = 0; ks < 4; ++ks) acc = MFMA16(frag(Ct, 136, me * 16, ks * 32, lane), qfr[ks], acc);
                acc = acc * wi;
#pragma unroll
                for (int ks = 0; ks < 2; ++ks) acc = MFMA16(frag(Vt, 72, me * 16, ks * 32, lane), pfr[ks], acc);
                Hacc[x] = acc; }
            const float den = shidx(Hacc[4][0], fr);
            const float inv = 1.f / fmaxf(fabsf(den), EN[tl]);
            float s = 0.f;
#pragma unroll
            for (int x = 0; x < 4; ++x) { Hacc[x] = Hacc[x] * inv; s += (Hacc[x][0] * Hacc[x][0] + Hacc[x][1] * Hacc[x][1]) + (Hacc[x][2] * Hacc[x][2] + Hacc[x][3] * Hacc[x][3]); }
            s += shx(s, 16, lane); s += shx(s, 32, lane);
            if (fq == 0) SSQ[half * 64 + tl] = s;
            __syncthreads();
            const float r = frsq((SSQ[tl] + SSQ[64 + tl]) * (1.f / 128.f) + EPS);
#pragma unroll
            for (int x = 0; x < 4; ++x) { const f32x4 g4 = *(const LAS f32x4*)(MGs + half * 64 + x * 16 + fq * 4);
                u32x2 o;
                o.x = pk2(sigmoidf_(bf_lo(mo[x].x)) * Hacc[x][0] * r * g4[0], sigmoidf_(bf_hi(mo[x].x)) * Hacc[x][1] * r * g4[1]);
                o.y = pk2(sigmoidf_(bf_lo(mo[x].y)) * Hacc[x][2] * r * g4[2], sigmoidf_(bf_hi(mo[x].y)) * Hacc[x][3] * r * g4[3]);
                *(u32x2*)(orow + x * 16) = o; }
        }
        {   const float decay = SC[0];
#pragma unroll
            for (int nt = 0; nt < 9; ++nt) Cacc[nt] = Cacc[nt] * decay;
#pragma unroll
            for (int ks = 0; ks < 2; ++ks) { const bf16x8 af = frag(KWt, 72, w * 16, ks * 32, lane);
#pragma unroll
                for (int nt = 0; nt < 9; ++nt) Cacc[nt] = MFMA16(af, frag(Vt, 72, nt * 16, ks * 32, lane), Cacc[nt]); }
#pragma unroll
            for (int nt = 0; nt < 9; ++nt) { u32x2 o; o.x = pk2(Cacc[nt][0], Cacc[nt][1]); o.y = pk2(Cacc[nt][2], Cacc[nt][3]);
                *(LAS u32x2*)(Ct + (nt * 16 + fr) * 136 + w * 16 + fq * 4) = o; }
        }
        __syncthreads();
    }
#undef ML_LOAD
}

__device__ __forceinline__ void gmlp_item(LAS unsigned char* lds, bf16_t* Z, const float* gnorm, const float* gws, const float* gbs, int b, int sp, int tid) {
    asm volatile("" : "+v"(tid));
    const int lane = tid & 63, w = __builtin_amdgcn_readfirstlane(tid >> 6), fr = lane & 15, fq = lane >> 4;
    LAS bf16_t* As = (LAS bf16_t*)lds;
    LAS bf16_t* Vt = As + 128 * 136;
    LAS float* ST = (LAS float*)(Vt + 128 * 136);
    const size_t rowbase = (size_t)b * SEQ + sp * 128;
#pragma unroll 1
    for (int tb = 0; tb < 2; ++tb) {
        u32x4 rawv[8];
#pragma unroll
        for (int i = 0; i < 8; ++i) rawv[i] = *(const u32x4*)(Z + (rowbase + w * 16 + tb * 8 + i) * LDZ + ZC_GV + lane * 8);
        float s[8], q[8];
#pragma unroll
        for (int i = 0; i < 8; ++i) { const u32x4 raw = rawv[i];
            float x[8]; x[0] = bf_lo(raw.x); x[1] = bf_hi(raw.x); x[2] = bf_lo(raw.y); x[3] = bf_hi(raw.y); x[4] = bf_lo(raw.z); x[5] = bf_hi(raw.z); x[6] = bf_lo(raw.w); x[7] = bf_hi(raw.w);
            s[i] = 0.f; q[i] = 0.f;
#pragma unroll
            for (int e = 0; e < 8; ++e) { x[e] = gelu_tanh(x[e]); s[i] += x[e]; q[i] += x[e] * x[e]; }
            u32x4 gw_; gw_.x = pk2(x[0], x[1]); gw_.y = pk2(x[2], x[3]); gw_.z = pk2(x[4], x[5]); gw_.w = pk2(x[6], x[7]);
            *(u32x4*)(Z + (rowbase + w * 16 + tb * 8 + i) * LDZ + ZC_GV + lane * 8) = gw_; }
#pragma unroll
        for (int o = 1; o < 64; o <<= 1) {
#pragma unroll
            for (int i = 0; i < 8; ++i) { s[i] += shx(s[i], o, lane); q[i] += shx(q[i], o, lane); } }
        if (lane < 8) {
            float sv = s[0], qv = q[0];
#pragma unroll
            for (int i = 1; i < 8; ++i) { if (lane == i) { sv = s[i]; qv = q[i]; } }
            const float mean = sv * (1.f / 512.f); const float var = fmaxf(qv * (1.f / 512.f) - mean * mean, 0.f);
            const int t = w * 16 + tb * 8 + lane; ST[2 * t] = mean; ST[2 * t + 1] = frsq(var + EPS);
        }
    }
    __syncthreads();
#pragma unroll 1
    for (int g = 0; g < 4; ++g) {
        const float* wsg = gws + (size_t)g * 128 * 128; const float* bsg = gbs + g * 128;
#pragma unroll
        for (int i = 0; i < 8; ++i) { const int idx = tid + 512 * i; const int t = idx >> 5, s4 = (idx & 31) * 4;
            f32x4 wv = *(const f32x4*)(wsg + t * 128 + s4); if ((t >> 6) < (s4 >> 6)) wv = (f32x4){0.f, 0.f, 0.f, 0.f};
            u32x2 o; o.x = pk2(wv[0], wv[1]); o.y = pk2(wv[2], wv[3]); *(LAS u32x2*)(As + t * 136 + s4) = o; }
#pragma unroll
        for (int i = 0; i < 2; ++i) { const int u = tid + 512 * i; const int tp = u >> 4, dcg = u & 15;
            const bf16_t* src0 = Z + (rowbase + 2 * tp) * LDZ + ZC_GV + g * 128 + dcg * 8;
            const u32x4 ra = *(const u32x4*)src0, rb = *(const u32x4*)(src0 + LDZ);
            const float m0 = ST[4 * tp], r0 = ST[4 * tp + 1], m1 = ST[4 * tp + 2], r1 = ST[4 * tp + 3];
            const f32x4 g0 = *(const f32x4*)(gnorm + g * 128 + dcg * 8), g1 = *(const f32x4*)(gnorm + g * 128 + dcg * 8 + 4);
            LAS bf16_t* vp = Vt + (dcg * 8) * 136 + 2 * tp;
            *(LAS unsigned*)(vp + 0 * 136) = pk2((bf_lo(ra.x) - m0) * r0 * g0[0], (bf_lo(rb.x) - m1) * r1 * g0[0]);
            *(LAS unsigned*)(vp + 1 * 136) = pk2((bf_hi(ra.x) - m0) * r0 * g0[1], (bf_hi(rb.x) - m1) * r1 * g0[1]);
            *(LAS unsigned*)(vp + 2 * 136) = pk2((bf_lo(ra.y) - m0) * r0 * g0[2], (bf_lo(rb.y) - m1) * r1 * g0[2]);
            *(LAS unsigned*)(vp + 3 * 136) = pk2((bf_hi(ra.y) - m0) * r0 * g0[3], (bf_hi(rb.y) - m1) * r1 * g0[3]);
            *(LAS unsigned*)(vp + 4 * 136) = pk2((bf_lo(ra.z) - m0) * r0 * g1[0], (bf_lo(rb.z) - m1) * r1 * g1[0]);
            *(LAS unsigned*)(vp + 5 * 136) = pk2((bf_hi(ra.z) - m0) * r0 * g1[1], (bf_hi(rb.z) - m1) * r1 * g1[1]);
            *(LAS unsigned*)(vp + 6 * 136) = pk2((bf_lo(ra.w) - m0) * r0 * g1[2], (bf_lo(rb.w) - m1) * r1 * g1[2]);
            *(LAS unsigned*)(vp + 7 * 136) = pk2((bf_hi(ra.w) - m0) * r0 * g1[3], (bf_hi(rb.w) - m1) * r1 * g1[3]);
        }
        __syncthreads();
        f32x4 acc[8];
#pragma unroll
        for (int mt = 0; mt < 8; ++mt) acc[mt] = (f32x4){0.f, 0.f, 0.f, 0.f};
        const int kmax = (w < 4) ? 2 : 4;
        for (int ks = 0; ks < kmax; ++ks) { const bf16x8 bfr = frag(As, 136, w * 16, ks * 32, lane);
#pragma unroll
            for (int mt = 0; mt < 8; ++mt) acc[mt] = MFMA16(frag(Vt, 136, mt * 16, ks * 32, lane), bfr, acc[mt]); }
        {   const int t = w * 16 + fr; const float bt = bsg[t];
            bf16_t* rowp = Z + (rowbase + t) * LDZ + ZC_GU + g * 128 + fq * 4;
            u32x2 uu[8];
#pragma unroll
            for (int mt = 0; mt < 8; ++mt) uu[mt] = *(const u32x2*)(rowp + mt * 16);
#pragma unroll
            for (int mt = 0; mt < 8; ++mt) { u32x2 o;
                o.x = pk2(gelu_tanh(bf_lo(uu[mt].x)) * (acc[mt][0] + bt), gelu_tanh(bf_hi(uu[mt].x)) * (acc[mt][1] + bt));
                o.y = pk2(gelu_tanh(bf_lo(uu[mt].y)) * (acc[mt][2] + bt), gelu_tanh(bf_hi(uu[mt].y)) * (acc[mt][3] + bt));
                *(u32x2*)(rowp + mt * 16) = o; } }
        __syncthreads();
    }
}

__device__ __forceinline__ void xattn_item(LAS unsigned char* lds, const bf16_t* Q, const bf16_t* KB, const bf16_t* VT, bf16_t* Oo, int b, int h, int qb, int tid) {
    asm volatile("" : "+v"(tid));
    const int lane = tid & 63, w = __builtin_amdgcn_readfirstlane(tid >> 6), fr = lane & 15, fq = lane >> 4;
    LAS bf16_t* Ks = (LAS bf16_t*)lds;
    LAS bf16_t* Vt = Ks + 64 * 264;
    LAS bf16_t* Ps = Vt + 256 * 72 + w * 16 * 264;
    const size_t qrow = (size_t)b * SEQ + qb * 128 + w * 16;
    bf16x8 qf[8];
#pragma unroll
    for (int ks = 0; ks < 8; ++ks) qf[ks] = *(const bf16x8*)(Q + (qrow + fr) * D + h * 256 + ks * 32 + fq * 8);
    u32x4 pre[4];
    const bf16_t* kbase = KB + (size_t)(b * 256 + (tid >> 5)) * 1024 + h * 256 + (tid & 31) * 8;
    const bf16_t* vbase = VT + ((size_t)(b * 1024 + h * 256 + (tid >> 3))) * 256 + (tid & 7) * 8;
#pragma unroll
    for (int i = 0; i < 4; ++i) pre[i] = *(const u32x4*)(kbase + (size_t)(16 * i) * 1024);
    f32x4 S[16];
#pragma unroll
    for (int kc = 0; kc < 4; ++kc) {
        __syncthreads();
#pragma unroll
        for (int i = 0; i < 4; ++i) *(LAS u32x4*)(Ks + ((tid >> 5) + 16 * i) * 264 + (tid & 31) * 8) = pre[i];
        if (kc < 3) {
#pragma unroll
            for (int i = 0; i < 4; ++i) pre[i] = *(const u32x4*)(kbase + (size_t)((kc + 1) * 64 + 16 * i) * 1024);
        } else {
#pragma unroll
            for (int i = 0; i < 4; ++i) pre[i] = *(const u32x4*)(vbase + (size_t)(64 * i) * 256);
        }
        __syncthreads();
#pragma unroll
        for (int nt = 0; nt < 4; ++nt) { f32x4 acc = (f32x4){0.f, 0.f, 0.f, 0.f};
#pragma unroll
            for (int ks = 0; ks < 8; ++ks) acc = MFMA16(qf[ks], frag(Ks, 264, nt * 16, ks * 32, lane), acc);
            S[kc * 4 + nt] = acc; }
    }
    float inv[4];
#pragma unroll
    for (int j = 0; j < 4; ++j) {
        float mx = -INFINITY;
#pragma unroll
        for (int i = 0; i < 16; ++i) mx = fmaxf(mx, S[i][j]);
        mx = fmaxf(mx, shx(mx, 1, lane)); mx = fmaxf(mx, shx(mx, 2, lane)); mx = fmaxf(mx, shx(mx, 4, lane)); mx = fmaxf(mx, shx(mx, 8, lane));
        float sum = 0.f;
#pragma unroll
        for (int i = 0; i < 16; ++i) { const float p = __expf((S[i][j] - mx) * 0.0625f); sum += p; Ps[(fq * 4 + j) * 264 + i * 16 + fr] = f2bf(p); }
        sum += shx(sum, 1, lane); sum += shx(sum, 2, lane); sum += shx(sum, 4, lane); sum += shx(sum, 8, lane);
        inv[j] = 1.f / sum;
    }
    float invq;
    {   const int srcl = (fr >> 2) * 16;
        const float i0 = shidx(inv[0], srcl), i1 = shidx(inv[1], srcl), i2 = shidx(inv[2], srcl), i3 = shidx(inv[3], srcl);
        invq = (fr & 3) == 0 ? i0 : ((fr & 3) == 1 ? i1 : ((fr & 3) == 2 ? i2 : i3)); }
    f32x4 O[16];
#pragma unroll
    for (int nt = 0; nt < 16; ++nt) O[nt] = (f32x4){0.f, 0.f, 0.f, 0.f};
#pragma unroll
    for (int kc = 0; kc < 4; ++kc) {
        __syncthreads();
#pragma unroll
        for (int i = 0; i < 4; ++i) *(LAS u32x4*)(Vt + ((tid >> 3) + 64 * i) * 72 + (tid & 7) * 8) = pre[i];
        if (kc < 3) {
#pragma unroll
            for (int i = 0; i < 4; ++i) pre[i] = *(const u32x4*)(vbase + (size_t)(64 * i) * 256 + (kc + 1) * 64);
        }
        __syncthreads();
#pragma unroll
        for (int ks = 0; ks < 2; ++ks) { const bf16x8 pf = frag(Ps, 264, 0, kc * 64 + ks * 32, lane);
#pragma unroll
            for (int nt = 0; nt < 16; ++nt) O[nt] = MFMA16(frag(Vt, 72, nt * 16, ks * 32, lane), pf, O[nt]); }
    }
    bf16_t* op = Oo + (qrow + fr) * D + h * 256 + fq * 4;
#pragma unroll
    for (int nt = 0; nt < 16; ++nt) { u32x2 o; o.x = pk2(O[nt][0] * invq, O[nt][1] * invq); o.y = pk2(O[nt][2] * invq, O[nt][3] * invq); *(u32x2*)(op + nt * 16) = o; }
    __syncthreads();
}

#define XB_TMO      128
#define XB_XCNT(j)  (256  + 64 * (j))
#define XB_XSUB(j)  (1280 + 64 * (j))
#define XB_XGEN(j)  (2304 + 64 * (j))
#define XB_TOP      3328
#define XB_TOPGEN   3392
#define XCD_BAR_WORDS 3456
#define XB_SPIN_CAP (1u << 18)

__device__ __forceinline__ unsigned xb_ld(unsigned* p)              { return __hip_atomic_load(p, __ATOMIC_RELAXED, __HIP_MEMORY_SCOPE_AGENT); }
__device__ __forceinline__ unsigned xb_add(unsigned* p, unsigned v) { return __hip_atomic_fetch_add(p, v, __ATOMIC_RELAXED, __HIP_MEMORY_SCOPE_AGENT); }
__device__ __forceinline__ unsigned xb_xcc_id() { return (unsigned)__builtin_amdgcn_s_getreg((3 << 11) | 20) & 0xFu; }
#define XB_SPIN(cond, bar) do { unsigned _sp = 0; while (cond) { __builtin_amdgcn_s_sleep(1); \
    if ((++_sp & 255u) == 0u) { if (xb_ld(&(bar)[XB_TMO])) break; if (_sp > XB_SPIN_CAP) { atomicAdd(&(bar)[XB_TMO], 1u); break; } } } } while (0)

struct XcdBarrier {
    unsigned* bar; unsigned x;
    volatile LAS unsigned* st;
};

__device__ __forceinline__ XcdBarrier xcd_barrier_post(unsigned* bar, volatile LAS unsigned* st) {
    XcdBarrier b; b.bar = bar; b.x = xb_xcc_id(); b.st = st;
    if (threadIdx.x == 0) (void)xb_add(&bar[XB_XCNT(b.x)], 1u);
    return b;
}
__device__ __forceinline__ void xcd_barrier_complete(unsigned* bar, unsigned x, unsigned& nloc, unsigned& nx) {
    const unsigned G = gridDim.x * gridDim.y * gridDim.z;
    unsigned sum, cnt, mine, sp = 0u;
    for (;;) {
        sum = 0u; cnt = 0u; mine = 0u;
#pragma unroll
        for (unsigned j = 0; j < 16; ++j) { const unsigned c = xb_ld(&bar[XB_XCNT(j)]); sum += c; cnt += (c > 0u) ? 1u : 0u; mine = (j == x) ? c : mine; }
        if (sum == G) break;
        __builtin_amdgcn_s_sleep(1);
        if ((++sp & 255u) == 0u) { if (xb_ld(&bar[XB_TMO])) break; if (sp > XB_SPIN_CAP) { atomicAdd(&bar[XB_TMO], 1u); break; } }
    }
    nloc = mine > 0u ? mine : 1u; nx = cnt > 0u ? cnt : 1u;
}

__device__ __forceinline__ void xcd_barrier(const XcdBarrier& b) {
    asm volatile("s_waitcnt vmcnt(0)" ::: "memory");
    __syncthreads();
    if (threadIdx.x == 0) {
        unsigned* bar = b.bar;
        __builtin_amdgcn_s_waitcnt(0);
        unsigned nloc = b.st[0], nx = b.st[1];
        if (nloc == 0u) { xcd_barrier_complete(bar, b.x, nloc, nx); b.st[0] = nloc; b.st[1] = nx; }
        const unsigned old = xb_add(&bar[XB_XSUB(b.x)], 1u);
        const unsigned gen = old / nloc;
        if (old + 1u == (gen + 1u) * nloc) {
            __builtin_amdgcn_fence(__ATOMIC_RELEASE, "agent");
            asm volatile("s_waitcnt vmcnt(0)" ::: "memory");
            const unsigned og = xb_add(&bar[XB_TOP], 1u);
            const unsigned tg = og / nx;
            if (og + 1u == (tg + 1u) * nx) xb_add(&bar[XB_TOPGEN], 1u);
            else XB_SPIN(xb_ld(&bar[XB_TOPGEN]) == tg, bar);
            __builtin_amdgcn_fence(__ATOMIC_ACQUIRE, "agent");
            xb_add(&bar[XB_XGEN(b.x)], 1u);
            asm volatile("s_waitcnt vmcnt(0)" ::: "memory");
        } else {
            XB_SPIN(xb_ld(&bar[XB_XGEN(b.x)]) == gen, bar);
            __builtin_amdgcn_fence(__ATOMIC_ACQUIRE, "agent");
            asm volatile("s_waitcnt vmcnt(0)" ::: "memory");
        }
    }
    __syncthreads();
}


struct Args { const float* in[17]; float* out; unsigned char* ws; int ph_lo, ph_hi; };
__global__ void __launch_bounds__(512, 2) fwd_kernel(Args a) {
    extern __shared__ __attribute__((aligned(16))) unsigned char lds_raw[];
    LAS unsigned char* lds = (LAS unsigned char*)lds_raw;
    constexpr int G = 256; const int bx = blockIdx.x;
    cg::grid_group grid = cg::this_grid();
    {   volatile LAS unsigned* st0 = (volatile LAS unsigned*)(lds + LDS_BYTES - 32);
        if (threadIdx.x < 2) st0[threadIdx.x] = 0u;
        __syncthreads(); }
    const XcdBarrier xbar = xcd_barrier_post((unsigned*)(a.ws + WS_CTL) + 1024, (volatile LAS unsigned*)(lds + LDS_BYTES - 32));
    const int wave0 = __builtin_amdgcn_readfirstlane((int)threadIdx.x >> 6);
    for (int ph = a.ph_lo; ph < a.ph_hi; ++ph) {
    if (ph != a.ph_lo) { if (ph == a.ph_lo + 1) grid.sync(); else xcd_barrier(xbar); }
    int tid; asm volatile("v_mbcnt_lo_u32_b32 %0, -1, 0\n\tv_mbcnt_hi_u32_b32 %0, -1, %0" : "=v"(tid)); tid += wave0 * 64;
    unsigned char* ws = a.ws;
    if (PROF_LO >= 0 && bx == 0 && tid == 0) {
        if (ph == PROF_LO && PROF_LO != 98) ((unsigned long long*)(ws + WS_CTL + 1024))[0] = __builtin_amdgcn_s_memrealtime();
        if (ph == PROF_HI && PROF_LO != 98) ((unsigned long long*)(ws + WS_CTL + 1024))[1] = __builtin_amdgcn_s_memrealtime();
    }
    const int lane = tid & 63, wave = __builtin_amdgcn_readfirstlane(tid >> 6);
    const int gw = bx * 8 + wave, NGW = G * 8, gtid = bx * 512 + tid, NGT = G * 512;
    bf16_t* ZH = (bf16_t*)(ws + WS_ZH); bf16_t* MRG = (bf16_t*)(ws + WS_MRG); bf16_t* KVb = (bf16_t*)(ws + WS_KV); bf16_t* MEMN = (bf16_t*)(ws + WS_MEMN);
    bf16_t* Y_A = ZH;
    bf16_t* H2A = (bf16_t*)(ws + WS_ZH + 64 * MiB);
    bf16_t* QB = (bf16_t*)(ws + WS_ZH + 128 * MiB);
    bf16_t* OB = (bf16_t*)(ws + WS_ZH + 192 * MiB);
    bf16_t* H2B = ZH;
    bf16_t* HID = (bf16_t*)(ws + WS_ZH + 64 * MiB);
    bf16_t* Win_t = (bf16_t*)(ws + WS_WIN); bf16_t* Wm_t = (bf16_t*)(ws + WS_WM); bf16_t* Wo_t = (bf16_t*)(ws + WS_WO); bf16_t* Wxq_t = (bf16_t*)(ws + WS_WXQ);
    bf16_t* Wxkv_t = (bf16_t*)(ws + WS_WXKV); bf16_t* Wxo_t = (bf16_t*)(ws + WS_WXO); bf16_t* W1_t = (bf16_t*)(ws + WS_W1); bf16_t* W2_t = (bf16_t*)(ws + WS_W2);
    const float* biasz = (const float*)(ws + WS_BIASZ);
    const float* x_in = a.in[0]; const float* mem = a.in[1]; const float* norms = a.in[2];
    float* xout = a.out;
    {
        if (ph == 0) {
            if (PROF_LO == 98) {
                if (bx == 0 && tid == 0) ((unsigned long long*)(ws + WS_CTL + 1024))[0] = __builtin_amdgcn_s_memrealtime();
                for (int i = 0; i < 16; ++i) xcd_barrier(xbar);
                if (bx == 0 && tid == 0) ((unsigned long long*)(ws + WS_CTL + 1024))[1] = __builtin_amdgcn_s_memrealtime();
            }
            LayerW L{a.in[3], a.in[4], a.in[10], a.in[11], a.in[12], a.in[13], a.in[14], a.in[15], a.in[16]};
            convert_weights(L, ws, lds, gw, NGW, wave, lane, gtid, NGT);
            norm_rows(x_in, nullptr, nullptr, nullptr, norms + 0 * D, ZH + HCOL, LDZ, MTOK, gw, NGW, lane);
            continue;
        }
        const int l = (ph - 1) / 12, k = (ph - 1) % 12 + 1;
        const float* gl = norms + (size_t)l * 7 * D;
        if (k == 1 || k == 4 || k == 6 || k == 8 || k == 10 || k == 11) {
            pg8::Gemm g; USched S; EpiStore E;
            S.G = G; S.c = bx; S.mode = 0; S.nM1 = 0; S.nN1 = 0; S.a1off = 0; S.b1off = 0; S.a0col = 0; S.nM0 = 128; S.nN0 = 4;
            E.O1 = nullptr; E.VT = nullptr; E.ldc1 = 0; E.bias = nullptr; E.act = 0; E.ldc0 = D;
            g.lda = D; g.K = D;
            if (k == 1) { g.A = ZH; g.Bt = Win_t; g.lda = LDZ; S.nN0 = 18; S.a0col = HCOL; E.O0 = ZH; E.ldc0 = LDZ; E.bias = biasz; }
            else if (k == 4) { g.A = MRG; g.Bt = Wo_t; E.O0 = Y_A; }
            else if (k == 6) { g.A = H2A; g.Bt = Wxq_t; S.mode = 1; S.nM1 = 16; S.nN1 = 8; S.a1off = (long)(MEMN - H2A); S.b1off = (long)(Wxkv_t - Wxq_t); E.O0 = QB; E.O1 = KVb; E.ldc1 = 1024; E.VT = KVb + (size_t)4096 * 1024; }
            else if (k == 8) { g.A = OB; g.Bt = Wxo_t; E.O0 = MRG; }
            else if (k == 10) { g.A = H2B; g.Bt = W1_t; S.nN0 = 16; E.O0 = HID; E.ldc0 = DFF; E.act = 2; }
            else { g.A = HID; g.Bt = W2_t; g.lda = DFF; g.K = DFF; E.O0 = MRG; }
            S.lda = g.lda; S.K = g.K;

#ifndef NO_GEMM
pg8::gemm_phase<EpiStore, USched, false>(lds, g, S, E, tid);
#endif
            if (k == 1) {
                const int fr = lane & 15, fq = lane >> 4;
                const size_t row0 = (size_t)bx * 128 + wave * 16;
                const bf16_t* ap = ZH + (row0 + fr) * LDZ + HCOL + fq * 8; const bf16_t* bp = Win_t + (size_t)(4608 + fr) * 1024 + fq * 8;
                f32x4 acc = (f32x4){0.f, 0.f, 0.f, 0.f};
#pragma unroll 1
                for (int k8 = 0; k8 < 4; ++k8) { bf16x8 av[8], bv[8];
#pragma unroll
                    for (int i = 0; i < 8; ++i) { av[i] = *(const bf16x8*)(ap + (k8 * 8 + i) * 32); bv[i] = *(const bf16x8*)(bp + (k8 * 8 + i) * 32); }
#pragma unroll
                    for (int i = 0; i < 8; ++i) acc = MFMA16(av[i], bv[i], acc); }
                const float bb = biasz[4608 + fr];
#pragma unroll
                for (int j = 0; j < 4; ++j) ZH[(row0 + fq * 4 + j) * LDZ + ZC_SM + fr] = f2bf(acc[j] + bb);
            }

        } else if (k == 3) {
            pg8::Gemm g; g.A = ZH; g.Bt = Wm_t; g.lda = LDZ; g.K = D;
            USched S; S.G = G; S.c = bx; S.mode = 2; S.nM0 = 128; S.nN0 = 4; S.nM1 = 0; S.nN1 = 0; S.a1off = 0; S.b1off = 0; S.a0col = 0; S.lda = LDZ; S.K = D;
            EpiMerge E; E.Z = ZH; E.MRG = MRG; E.gbias = a.in[4] + (size_t)l * DIN + 4624;

#ifndef NO_MERGE
pg8::gemm_phase<EpiMerge, USched, true>(lds, g, S, E, tid);
#endif

        } else if (k == 2) {
            unsigned* ctr = (unsigned*)(ws + WS_CTL) + 64 * (l + 1);
            LAS int* qslot = (LAS int*)(lds + LDS_BYTES - 64);
            const float* convw = a.in[5] + (size_t)l * 4 * 1024; const float* mg = a.in[6] + (size_t)l * 512; const float* gnorm = a.in[7] + (size_t)l * 512;
            const float* gws = a.in[8] + (size_t)l * 4 * 128 * 128; const float* gbs = a.in[9] + (size_t)l * 4 * 128;
#define FETCH_ITEM() ({ __syncthreads(); if (tid == 0) *qslot = (int)atomicAdd(ctr, 1u); __syncthreads(); __builtin_amdgcn_readfirstlane(*qslot); })
            int it = FETCH_ITEM();
            while (it < 64) {
#ifndef NO_MLSTM
                mlstm_item(lds, ZH, convw, mg, it >> 2, it & 3, tid);
#endif
                if (PROF_HI == 97 && l == 0 && tid == 0) atomicMax((unsigned long long*)(ws + WS_CTL + 1024) + 1, (unsigned long long)__builtin_amdgcn_s_memrealtime());
                it = FETCH_ITEM();
            }
            while (it < 64 + 1024) {
                const int r = it - 64; const int bh = r >> 3, pp = 7 - (r & 7);
#ifndef NO_FOX
                fox_item(lds, ZH, bh >> 3, bh & 7, pp, tid);
#endif
                if (PROF_HI == 96 && l == 0 && tid == 0) atomicMax((unsigned long long*)(ws + WS_CTL + 1024) + 1, (unsigned long long)__builtin_amdgcn_s_memrealtime());
                it = FETCH_ITEM();
            }
            while (it < 64 + 1024 + 256) {
                const int r = it - 1088; const int sp = r & 15, bb = r >> 4;
#ifndef NO_GMLP
                gmlp_item(lds, ZH, gnorm, gws, gbs, bb, sp, tid);
#endif
                it = FETCH_ITEM();
            }
#undef FETCH_ITEM
        } else if (k == 7) {

#ifndef NO_XATTN
for (int it = bx; it < 1024; it += G) xattn_item(lds, QB, KVb, KVb + (size_t)4096 * 1024, OB, it >> 6, (it >> 4) & 3, it & 15, tid);
#endif

        } else if (k == 5) {
            norm_rows(l == 0 ? x_in : xout, xout, Y_A, gl + 1 * D, gl + 2 * D, H2A, D, MTOK, gw, NGW, lane);
            norm_rows(mem, nullptr, nullptr, nullptr, gl + 4 * D, MEMN, D, MEMR, gw, NGW, lane);
        } else if (k == 9) {
            norm_rows(xout, xout, MRG, gl + 3 * D, gl + 5 * D, H2B, D, MTOK, gw, NGW, lane);
        } else {
            if (l + 1 < DEPTH) {
                norm_rows(xout, xout, MRG, gl + 6 * D, norms + (size_t)(l + 1) * 7 * D, ZH + HCOL, LDZ, MTOK, gw, NGW, lane);
                const int n = l + 1;
                LayerW L{a.in[3] + (size_t)n * D * DIN, a.in[4] + (size_t)n * DIN, a.in[10] + (size_t)n * 3 * 512 * 1024, a.in[11] + (size_t)n * D * D, a.in[12] + (size_t)n * D * D,
                         a.in[13] + (size_t)n * D * 2 * D, a.in[14] + (size_t)n * D * D, a.in[15] + (size_t)n * D * DFF, a.in[16] + (size_t)n * DFF * D};
                convert_weights(L, ws, lds, gw, NGW, wave, lane, gtid, NGT);
            } else {
                norm_rows(xout, xout, MRG, gl + 6 * D, nullptr, nullptr, 0, MTOK, gw, NGW, lane);
                if (PROF_LO >= 0 && bx == 0) {
                    __syncthreads();
                    const unsigned long long* pt = (const unsigned long long*)(ws + WS_CTL + 1024);
                    long n = (PROF_LO == 99) ? 4000 : (long)((pt[1] - pt[0]) / 100ull);
                    if (n > 8192) n = 8192;
                    for (int i = tid; i < n; i += 512) xout[i] += 0.25f;
                }
            }
        }
    }
    }
}

extern "C" void kernel_launch(void* const* d_in, const int* in_sizes, int n_in, void* d_out, int out_size, void* d_ws, size_t ws_size, hipStream_t stream) {
    static int grid = 0;
    if (grid == 0) {
        if (n_in != 17 || ws_size < WS_END) { fprintf(stderr, "kernel_launch: unexpected n_in %d or ws_size %zu (< %zu)\n", n_in, ws_size, (size_t)WS_END); grid = -1; return; }
        int dev = 0, cus = 0, per_cu = 0;
        (void)hipGetDevice(&dev);
        (void)hipDeviceGetAttribute(&cus, hipDeviceAttributeMultiprocessorCount, dev);
        if (hipFuncSetAttribute((const void*)fwd_kernel, hipFuncAttributeMaxDynamicSharedMemorySize, LDS_BYTES) != hipSuccess) { fprintf(stderr, "kernel_launch: hipFuncSetAttribute failed\n"); }
        if (hipOccupancyMaxActiveBlocksPerMultiprocessor(&per_cu, (const void*)fwd_kernel, 512, LDS_BYTES) != hipSuccess || per_cu < 1) { fprintf(stderr, "kernel_launch: occupancy query says %d\n", per_cu); per_cu = 1; }
        (void)hipGetLastError();
        if (cus <= 0) cus = 256;
        if (cus < 256) fprintf(stderr, "kernel_launch: device reports %d CUs; this kernel is built for a 256-workgroup cooperative grid\n", cus);
        grid = 256;
    }
    if (grid < 0) return;
    (void)hipMemsetAsync((char*)d_ws + WS_CTL, 0, 32768, stream);
    Args a{};
    for (int i = 0; i < 17; ++i) a.in[i] = (const float*)d_in[i];
    a.out = (float*)d_out; a.ws = (unsigned char*)d_ws;
#if MK_MULTI
    for (int ph = 0; ph < NPHASE; ++ph) {
        a.ph_lo = ph; a.ph_hi = ph + 1;
        hipLaunchKernelGGL(fwd_kernel, dim3(grid), dim3(512), LDS_BYTES, stream, a);
    }
#else
    a.ph_lo = 0; a.ph_hi = NPHASE;
    void* args[] = {&a};
    hipError_t e = hipLaunchCooperativeKernel((const void*)fwd_kernel, dim3(grid), dim3(512), args, LDS_BYTES, stream);
    if (e != hipSuccess) fprintf(stderr, "cooperative launch failed: %s (grid %d)\n", hipGetErrorString(e), grid);
#endif
}
```

```cpp
#include <hip/hip_runtime.h>
#include <hip/hip_cooperative_groups.h>
#include <cstdio>
#include <cstdint>
namespace cg = cooperative_groups;

#ifndef MK_MULTI
#define MK_MULTI 0
#endif

#ifndef PROF_LO
#define PROF_LO -1
#define PROF_HI -1
#endif
#define LAS __attribute__((address_space(3)))
typedef unsigned short bf16_t;
typedef short bf16x8 __attribute__((ext_vector_type(8)));
typedef float f32x4 __attribute__((ext_vector_type(4)));
typedef unsigned u32x4 __attribute__((ext_vector_type(4)));
typedef unsigned u32x2 __attribute__((ext_vector_type(2)));
typedef float f32x2_t __attribute__((ext_vector_type(2)));
typedef __bf16 bf16x2_t __attribute__((ext_vector_type(2)));

namespace pg8 {
#define PG8_LAS __attribute__((address_space(3)))
constexpr int BM = 256, BK = 64, HALF = 128, HTB = HALF * BK * 2, STAGE_BYTES = 8 * HTB, NXCD = 8, WGM = 8;

__host__ __device__ __forceinline__ int lds_byte(int r, int c) { const int st = (r >> 4) * 2 + (c >> 5), rr = r & 15, cc = c & 31, ob = rr * 64 + cc * 2; return st * 1024 + (ob ^ (((ob >> 9) & 1) << 5)); }
__host__ __device__ __forceinline__ void stage_rc(int b, int& R, int& C) { const int st = b / 1024, sb = b % 1024, swz = sb ^ (((sb >> 9) & 1) << 5); R = (st >> 1) * 16 + swz / 64; C = (st & 1) * 32 + (swz % 64) / 2; }
__host__ __device__ __forceinline__ int perm32(int rho) { const int n = rho >> 4, i = rho & 15; return 8 * (i >> 2) + 4 * n + (i & 3); }

struct Unit { int pm, pn, sub, nt; long aoff, boff; };
struct Gemm { const bf16_t* A; const bf16_t* Bt; int lda, K; };

template <class Epi, class Sched, bool ALIGN_EPI>
__device__ __forceinline__ void gemm_phase(PG8_LAS unsigned char* lds, const Gemm g, const Sched& S, const Epi& E, int tid) {
    asm volatile("" : "+v"(tid));
    const int wid = __builtin_amdgcn_readfirstlane(tid >> 6), lane = tid & 63, wr = wid >> 2, wc = wid & 3, fr = lane & 15, fq = lane >> 4;
    const int K = g.K, lda = g.lda;
    unsigned voffA[2], voffB[2];
#pragma unroll
    for (int i = 0; i < 2; ++i) { int R, C; stage_rc(tid * 16 + i * 8192, R, C); const int Rb = Epi::PERM ? ((R & ~31) + perm32(R & 31)) : R;
        voffA[i] = (unsigned)(R * lda + C) * 2u; voffB[i] = (unsigned)(Rb * K + C) * 2u; }
    const size_t kstep = (size_t)(BK * 2);
    const size_t hstepA = (size_t)HALF * lda * 2, hstepB = (size_t)HALF * K * 2;
    const unsigned ldsw = (unsigned)wid * 1024u;
    const int aoff = lds_byte(wr * 64 + fr, fq * 8), boff = lds_byte(wc * 32 + fr, fq * 8);
#define PG8_SA(b, h) (((b) * 2 + (h)) * HTB)
#define PG8_SB(b, h) ((4 + (b) * 2 + (h)) * HTB)
#define PG8_STAGE(bufoff, gbase, voff) do { _Pragma("unroll") for (int _i = 0; _i < 2; ++_i) \
        __builtin_amdgcn_global_load_lds((const unsigned*)((const char*)(gbase) + (voff)[_i]), (PG8_LAS unsigned*)(lds + (bufoff) + ldsw + _i * 8192), 16, 0, 0); } while (0)
#define PG8_LDA(dst, b, h) do { _Pragma("unroll") for (int m = 0; m < 4; ++m) _Pragma("unroll") for (int k = 0; k < 2; ++k) dst[m][k] = *(const PG8_LAS bf16x8*)(lds + PG8_SA(b, h) + aoff + m * 2048 + k * 1024); } while (0)
#define PG8_LDB(dst, b, h) do { _Pragma("unroll") for (int n = 0; n < 2; ++n) _Pragma("unroll") for (int k = 0; k < 2; ++k) dst[n][k] = *(const PG8_LAS bf16x8*)(lds + PG8_SB(b, h) + boff + n * 2048 + k * 1024); } while (0)
#define PG8_MMA(ai, bj, At, Bt) do { __builtin_amdgcn_s_setprio(1); _Pragma("unroll") for (int m = 0; m < 4; ++m) _Pragma("unroll") for (int n = 0; n < 2; ++n) _Pragma("unroll") for (int k = 0; k < 2; ++k) \
        acc[ai][bj][m][n] = __builtin_amdgcn_mfma_f32_16x16x32_bf16(Bt[n][k], At[m][k], acc[ai][bj][m][n], 0, 0, 0); __builtin_amdgcn_s_setprio(0); } while (0)
#define PG8_WAIT_V(n) asm volatile("s_waitcnt vmcnt(" #n ")" ::: "memory")
#define PG8_WAIT_L(n) asm volatile("s_waitcnt lgkmcnt(" #n ")" ::: "memory")
#define PG8_BAR __builtin_amdgcn_s_barrier()
#define PG8_SCHED __builtin_amdgcn_sched_barrier(0)
    Unit cur, nxt; int ui = 0;
    if (!S.next(0, cur)) return;
    int nt = cur.nt;
    f32x4 acc[2][2][4][2];
#pragma unroll
    for (int a = 0; a < 2; ++a)
#pragma unroll
        for (int b = 0; b < 2; ++b)
#pragma unroll
            for (int m = 0; m < 4; ++m)
#pragma unroll
                for (int n = 0; n < 2; ++n) acc[a][b][m][n] = (f32x4){0.f, 0.f, 0.f, 0.f};
    bf16x8 At[4][2], B0[2][2], B1[2][2];
    const char* cA = (const char*)g.A + cur.aoff * 2; const char* cB = (const char*)g.Bt + cur.boff * 2;
    PG8_STAGE(PG8_SB(0, 0), cB, voffB); PG8_STAGE(PG8_SB(0, 1), cB + hstepB, voffB); PG8_STAGE(PG8_SA(0, 0), cA, voffA); PG8_STAGE(PG8_SA(0, 1), cA + hstepA, voffA);
    if (wr == 1) PG8_BAR;
    PG8_WAIT_V(2); PG8_BAR;
    PG8_STAGE(PG8_SB(1, 0), cB + kstep, voffB); PG8_STAGE(PG8_SA(1, 0), cA + kstep, voffA); PG8_STAGE(PG8_SB(1, 1), cB + hstepB + kstep, voffB);
    PG8_WAIT_V(6); PG8_BAR;
    for (;;) {
        const bool has_next = S.next(ui + 1, nxt);
        const char* nA = has_next ? (const char*)g.A + nxt.aoff * 2 : cA; const char* nB = has_next ? (const char*)g.Bt + nxt.boff * 2 : cB;
        for (int t = 0; t < nt; t += 2) {
            const bool last = (t == nt - 2);
            const char* a1 = cA + (size_t)(t + 1) * kstep;
            const char* a2 = last ? nA : cA + (size_t)(t + 2) * kstep; const char* b2 = last ? nB : cB + (size_t)(t + 2) * kstep;
            const char* a3 = a2 + kstep; const char* b3 = b2 + kstep;
            PG8_LDB(B0, 0, 0); PG8_LDB(B1, 0, 1); PG8_SCHED; PG8_LDA(At, 0, 0); PG8_STAGE(PG8_SA(1, 1), a1 + hstepA, voffA);
            PG8_WAIT_V(8); PG8_WAIT_L(0); PG8_BAR; PG8_MMA(0, 0, At, B0); PG8_MMA(0, 1, At, B1); PG8_BAR; PG8_SCHED;
            PG8_LDA(At, 0, 1); PG8_STAGE(PG8_SB(0, 0), b2, voffB); PG8_STAGE(PG8_SB(0, 1), b2 + hstepB, voffB); PG8_STAGE(PG8_SA(0, 0), a2, voffA);
            PG8_WAIT_V(8); PG8_WAIT_L(0); PG8_BAR; PG8_MMA(1, 0, At, B0); PG8_MMA(1, 1, At, B1); PG8_BAR; PG8_SCHED;
            PG8_LDB(B0, 1, 0); PG8_LDB(B1, 1, 1); PG8_SCHED; PG8_LDA(At, 1, 0); PG8_STAGE(PG8_SA(0, 1), a2 + hstepA, voffA);
            PG8_WAIT_V(8); PG8_WAIT_L(0); PG8_BAR; PG8_MMA(0, 0, At, B0); PG8_MMA(0, 1, At, B1); PG8_BAR; PG8_SCHED;
            PG8_LDA(At, 1, 1); PG8_STAGE(PG8_SB(1, 0), b3, voffB); PG8_STAGE(PG8_SB(1, 1), b3 + hstepB, voffB); PG8_STAGE(PG8_SA(1, 0), a3, voffA);
            PG8_WAIT_V(8); PG8_WAIT_L(0); PG8_BAR; PG8_MMA(1, 0, At, B0); PG8_MMA(1, 1, At, B1); PG8_BAR; PG8_SCHED;
        }
        if constexpr (ALIGN_EPI) { if (wr == 0) PG8_BAR; }
        E(acc, cur, wr, wc, fr, fq);
        if (!has_next) break;
#pragma unroll
        for (int a = 0; a < 2; ++a)
#pragma unroll
            for (int b = 0; b < 2; ++b)
#pragma unroll
                for (int m = 0; m < 4; ++m)
#pragma unroll
                    for (int n = 0; n < 2; ++n) acc[a][b][m][n] = (f32x4){0.f, 0.f, 0.f, 0.f};
        cur = nxt; cA = nA; cB = nB; ++ui; nt = cur.nt;
        if constexpr (ALIGN_EPI) { if (wr == 1) PG8_BAR; }
    }
    PG8_WAIT_V(0);
    if constexpr (!ALIGN_EPI) { if (wr == 0) PG8_BAR; }
    PG8_BAR;
#undef PG8_SA
#undef PG8_SB
#undef PG8_STAGE
#undef PG8_LDA
#undef PG8_LDB
#undef PG8_MMA
#undef PG8_WAIT_V
#undef PG8_WAIT_L
#undef PG8_BAR
#undef PG8_SCHED
}
}

constexpr int D = 1024, BATCH = 16, SEQ = 2048, MTOK = BATCH * SEQ, DEPTH = 2, MEMR = 16 * 256, DFF = 4096, DIN = 7696;
constexpr int LDZ = 5888, HCOL = 4864;
constexpr int ZC_FQ = 0, ZC_FK = 512, ZC_FV = 1024, ZC_MQ = 1536, ZC_MK = 2048, ZC_MV = 2560, ZC_MO = 3072, ZC_GU = 3584, ZC_GV = 4096, ZC_SM = 4608;
constexpr int ZC_SCR = 1024;
constexpr float EPS = 1e-6f;
constexpr int NPHASE = 25;
constexpr int LDS_BYTES = 147456;

constexpr size_t MiB = 1u << 20;
constexpr size_t WS_CTL = 0;
constexpr size_t WS_WIN = 1 * MiB;
constexpr size_t WS_WM = WS_WIN + (size_t)4864 * 1024 * 2;
constexpr size_t WS_WO = WS_WM + (size_t)6144 * 1024 * 2;
constexpr size_t WS_WXQ = WS_WO + 2 * MiB;
constexpr size_t WS_WXKV = WS_WXQ + 2 * MiB;
constexpr size_t WS_WXO = WS_WXKV + 4 * MiB;
constexpr size_t WS_W1 = WS_WXO + 2 * MiB;
constexpr size_t WS_W2 = WS_W1 + 8 * MiB;
constexpr size_t WS_BIASZ = WS_W2 + 8 * MiB;
constexpr size_t WS_KV = 50 * MiB;
constexpr size_t WS_MEMN = 66 * MiB;
constexpr size_t WS_ZH = 74 * MiB;
constexpr size_t WS_MRG = 442 * MiB;
constexpr size_t WS_END = 506 * MiB;
static_assert(WS_BIASZ + 4864 * 4 <= WS_KV, "ws map");

__device__ __forceinline__ float bf_lo(unsigned u) { return __uint_as_float(u << 16); }
__device__ __forceinline__ float bf_hi(unsigned u) { return __uint_as_float(u & 0xffff0000u); }
__device__ __forceinline__ float bf2f(bf16_t b) { return __uint_as_float(((unsigned)b) << 16); }
__device__ __forceinline__ unsigned pk2(float lo, float hi) { f32x2_t v = {lo, hi}; bf16x2_t b = __builtin_convertvector(v, bf16x2_t); return __builtin_bit_cast(unsigned, b); }
__device__ __forceinline__ bf16_t f2bf(float f) { return (bf16_t)(pk2(f, 0.f) & 0xffffu); }
__device__ __forceinline__ float shidx(float v, int src) { return __int_as_float(__builtin_amdgcn_ds_bpermute(src << 2, __float_as_int(v))); }
__device__ __forceinline__ float shx(float v, int m, int lane) { return shidx(v, lane ^ m); }
__device__ __forceinline__ float shup(float v, int o, int lane) { return shidx(v, (lane - o) & 63); }
__device__ __forceinline__ float wave_sum(float v, int lane) {
#pragma unroll
    for (int o = 1; o < 64; o <<= 1) v += shx(v, o, lane);
    return v;
}
__device__ __forceinline__ float frcp(float x) { return __builtin_amdgcn_rcpf(x); }
__device__ __forceinline__ float frsq(float x) { return __builtin_amdgcn_rsqf(x); }
__device__ __forceinline__ float sigmoidf_(float x) { return frcp(1.f + __expf(-x)); }
__device__ __forceinline__ float logsigmoidf_(float x) { return fminf(x, 0.f) - __logf(1.f + __expf(-fabsf(x))); }
__device__ __forceinline__ float gelu_tanh(float x) { const float u = 0.7978845608028654f * (x + 0.044715f * x * x * x); const float t = 1.f - 2.f * frcp(__expf(2.f * u) + 1.f); return 0.5f * x * (1.f + t); }
#define MFMA16(a, b, c) __builtin_amdgcn_mfma_f32_16x16x32_bf16((a), (b), (c), 0, 0, 0)
__device__ __forceinline__ bf16x8 frag(const LAS bf16_t* p, int ld, int row0, int k0, int lane) { return *(const LAS bf16x8*)(p + (row0 + (lane & 15)) * ld + k0 + (lane >> 4) * 8); }
#define LDS_FENCE() asm volatile("s_waitcnt lgkmcnt(0)" ::: "memory")

__device__ __forceinline__ void tile_map(int wgid, int nM, int nN, int& pm, int& pn) {
    const int nwg = nM * nN;
    { const int q = nwg / pg8::NXCD, r = nwg % pg8::NXCD, xcd = wgid % pg8::NXCD, off = wgid / pg8::NXCD; wgid = (xcd < r ? xcd * (q + 1) : r * (q + 1) + (xcd - r) * q) + off; }
    const int nig = pg8::WGM * nN, gid = wgid / nig, fm = gid * pg8::WGM, gsz = (nM - fm) < pg8::WGM ? (nM - fm) : pg8::WGM;
    pm = fm + ((wgid % nig) % gsz); pn = (wgid % nig) / gsz;
}
struct USched {
    int mode;
    int G, c, nM0, nN0, nM1, nN1;
    long lda, K, a0col, a1off, b1off;
    __device__ __forceinline__ bool next(int i, pg8::Unit& u) const {
        if (mode == 2) {
            const int ti = i / 6, s = i - ti * 6; const long L = (long)ti * G + c; if (L >= (long)nM0 * nN0) return false;
            int pm, pn; tile_map((int)L, nM0, nN0, pm, pn);
            const int n = s >> 1, br = s & 1;
            const long acol = br ? (n == 0 ? (long)ZC_FQ : (n == 1 ? (long)ZC_MO : (long)ZC_GU)) : (long)HCOL;
            u.pm = pm; u.pn = pn; u.sub = s; u.nt = br ? 8 : 16; u.aoff = (long)pm * 256 * lda + acol; u.boff = ((long)(br ? 3072 : 0) + n * 1024 + pn * 256) * K; return true;
        }
        const long L = (long)i * G + c; const long n0 = (long)nM0 * nN0;
        if (L < n0) { int pm, pn; tile_map((int)L, nM0, nN0, pm, pn); u.pm = pm; u.pn = pn; u.sub = 0; u.nt = (int)(K >> 6); u.aoff = (long)pm * 256 * lda + a0col; u.boff = (long)pn * 256 * K; return true; }
        if (mode == 1 && L < n0 + (long)nM1 * nN1) { int pm, pn; tile_map((int)(L - n0), nM1, nN1, pm, pn); u.pm = pm; u.pn = pn; u.sub = 1; u.nt = (int)(K >> 6); u.aoff = a1off + (long)pm * 256 * lda; u.boff = b1off + (long)pn * 256 * K; return true; }
        return false;
    }
};

struct EpiStore {
    static constexpr bool PERM = true;
    bf16_t* O0; bf16_t* O1; bf16_t* VT; int ldc0, ldc1, act; const float* bias;
    __device__ __forceinline__ void operator()(const f32x4 (&acc)[2][2][4][2], const pg8::Unit& u, int wr, int wc, int fr, int fq) const {
        bf16_t* base = u.sub ? O1 : O0; const int ldc = u.sub ? ldc1 : ldc0;
        const int row0 = u.pm * 256 + wr * 64 + fr, col0 = u.pn * 256 + wc * 32 + 8 * fq;
        if (u.sub && u.pn >= 4) {
#pragma unroll
            for (int ai = 0; ai < 2; ++ai)
#pragma unroll
                for (int m = 0; m < 4; ++m) { const int r = row0 + ai * 128 + m * 16; bf16_t* vp = VT + ((size_t)(r >> 8) * 1024 + (col0 - 1024)) * 256 + (r & 255);
#pragma unroll
                    for (int bj = 0; bj < 2; ++bj)
#pragma unroll
                        for (int n = 0; n < 2; ++n)
#pragma unroll
                            for (int e = 0; e < 4; ++e) vp[(size_t)(bj * 128 + n * 4 + e) * 256] = f2bf(acc[ai][bj][m][n][e]); }
            return;
        }
        f32x4 bv[2][2];
#pragma unroll
        for (int bj = 0; bj < 2; ++bj)
#pragma unroll
            for (int n = 0; n < 2; ++n) bv[bj][n] = bias ? *(const f32x4*)(bias + col0 + bj * 128 + 4 * n) : (f32x4){0.f, 0.f, 0.f, 0.f};
#pragma unroll
        for (int ai = 0; ai < 2; ++ai)
#pragma unroll
            for (int m = 0; m < 4; ++m) { bf16_t* rowp = base + (size_t)(row0 + ai * 128 + m * 16) * ldc + col0;
#pragma unroll
                for (int bj = 0; bj < 2; ++bj) { f32x4 v0 = acc[ai][bj][m][0] + bv[bj][0], v1 = acc[ai][bj][m][1] + bv[bj][1];
                    if (act == 2) {
#pragma unroll
                        for (int e = 0; e < 4; ++e) { const float a0 = fmaxf(v0[e], 0.f), a1 = fmaxf(v1[e], 0.f); v0[e] = a0 * a0; v1[e] = a1 * a1; } }
                    u32x4 w; w.x = pk2(v0[0], v0[1]); w.y = pk2(v0[2], v0[3]); w.z = pk2(v1[0], v1[1]); w.w = pk2(v1[2], v1[3]);
                    *(u32x4*)(rowp + bj * 128) = w; } }
    }
};
struct EpiMerge {
    static constexpr bool PERM = true, FUSED = false;
    bf16_t* Z; bf16_t* MRG; const float* gbias;
    __device__ __forceinline__ void operator()(const f32x4 (&acc)[2][2][4][2], const pg8::Unit& u, int wr, int wc, int fr, int fq) const {
        const int n = u.sub >> 1, br = u.sub & 1;
        const int row0 = u.pm * 256 + wr * 64 + fr, col0 = u.pn * 256 + wc * 32 + 8 * fq;
        if (!br) {
            f32x4 gb[2][2];
#pragma unroll
            for (int bj = 0; bj < 2; ++bj) { gb[bj][0] = *(const f32x4*)(gbias + n * 1024 + col0 + bj * 128); gb[bj][1] = *(const f32x4*)(gbias + n * 1024 + col0 + bj * 128 + 4); }
#pragma unroll
            for (int ai = 0; ai < 2; ++ai)
#pragma unroll
                for (int m = 0; m < 4; ++m) { bf16_t* sp = Z + (size_t)(row0 + ai * 128 + m * 16) * LDZ + ZC_SCR + col0;
#pragma unroll
                    for (int bj = 0; bj < 2; ++bj) { f32x4 v0 = acc[ai][bj][m][0], v1 = acc[ai][bj][m][1];
#pragma unroll
                        for (int e = 0; e < 4; ++e) { v0[e] = sigmoidf_(v0[e] + gb[bj][0][e]); v1[e] = sigmoidf_(v1[e] + gb[bj][1][e]); }
                        u32x4 w; w.x = pk2(v0[0], v0[1]); w.y = pk2(v0[2], v0[3]); w.z = pk2(v1[0], v1[1]); w.w = pk2(v1[2], v1[3]);
                        *(u32x4*)(sp + bj * 128) = w; } }
        } else {
#pragma unroll
            for (int ai = 0; ai < 2; ++ai) {
                u32x4 sv[4][2], qv[4][2];
#pragma unroll
                for (int m = 0; m < 4; ++m) { const size_t row = (size_t)(row0 + ai * 128 + m * 16);
#pragma unroll
                    for (int bj = 0; bj < 2; ++bj) { sv[m][bj] = *(const u32x4*)(Z + row * LDZ + ZC_SCR + col0 + bj * 128);
                        qv[m][bj] = (n > 0) ? *(const u32x4*)(MRG + row * D + col0 + bj * 128) : (u32x4){0u, 0u, 0u, 0u}; } }
#pragma unroll
                for (int m = 0; m < 4; ++m) { bf16_t* mp = MRG + (size_t)(row0 + ai * 128 + m * 16) * D + col0;
#pragma unroll
                    for (int bj = 0; bj < 2; ++bj) { f32x4 v0 = acc[ai][bj][m][0], v1 = acc[ai][bj][m][1]; const u32x4 s = sv[m][bj], q = qv[m][bj];
                        v0[0] = v0[0] * bf_lo(s.x) + bf_lo(q.x); v0[1] = v0[1] * bf_hi(s.x) + bf_hi(q.x); v0[2] = v0[2] * bf_lo(s.y) + bf_lo(q.y); v0[3] = v0[3] * bf_hi(s.y) + bf_hi(q.y);
                        v1[0] = v1[0] * bf_lo(s.z) + bf_lo(q.z); v1[1] = v1[1] * bf_hi(s.z) + bf_hi(q.z); v1[2] = v1[2] * bf_lo(s.w) + bf_lo(q.w); v1[3] = v1[3] * bf_hi(s.w) + bf_hi(q.w);
                        u32x4 w; w.x = pk2(v0[0], v0[1]); w.y = pk2(v0[2], v0[3]); w.z = pk2(v1[0], v1[1]); w.w = pk2(v1[2], v1[3]);
                        *(u32x4*)(mp + bj * 128) = w; } }
            }
        }
    }
};

__device__ __forceinline__ void norm_rows(const float* xsrc, float* xdst, const bf16_t* y, const float* gpost, const float* gpre, bf16_t* hout, int ldh, int nrows, int gw, int NGW, int lane) {
#pragma unroll 1
    for (int m = gw; m < nrows; m += 2 * NGW) {
        f32x4 v[2][4];
#pragma unroll
        for (int q = 0; q < 2; ++q) { const f32x4* xr = (const f32x4*)(xsrc + (size_t)(m + q * NGW) * D) + lane;
#pragma unroll
            for (int j = 0; j < 4; ++j) v[q][j] = xr[64 * j]; }
        if (y) {
            f32x4 yv[2][4]; float ss[2];
#pragma unroll
            for (int q = 0; q < 2; ++q) { const u32x2* yr = (const u32x2*)(y + (size_t)(m + q * NGW) * D) + lane; ss[q] = 0.f;
#pragma unroll
                for (int j = 0; j < 4; ++j) { const u32x2 t = yr[64 * j]; yv[q][j] = (f32x4){bf_lo(t.x), bf_hi(t.x), bf_lo(t.y), bf_hi(t.y)};
                    ss[q] += (yv[q][j][0] * yv[q][j][0] + yv[q][j][1] * yv[q][j][1]) + (yv[q][j][2] * yv[q][j][2] + yv[q][j][3] * yv[q][j][3]); } }
#pragma unroll
            for (int q = 0; q < 2; ++q) { const float r = frsq(wave_sum(ss[q], lane) * (1.f / D) + EPS);
                f32x4* xo = (f32x4*)(xdst + (size_t)(m + q * NGW) * D) + lane;
#pragma unroll
                for (int j = 0; j < 4; ++j) { const f32x4 gp = ((const f32x4*)gpost)[lane + 64 * j]; v[q][j] = v[q][j] + yv[q][j] * r * gp; xo[64 * j] = v[q][j]; } }
        }
        if (hout) {
#pragma unroll
            for (int q = 0; q < 2; ++q) { float ss = 0.f;
#pragma unroll
                for (int j = 0; j < 4; ++j) ss += (v[q][j][0] * v[q][j][0] + v[q][j][1] * v[q][j][1]) + (v[q][j][2] * v[q][j][2] + v[q][j][3] * v[q][j][3]);
                const float r = frsq(wave_sum(ss, lane) * (1.f / D) + EPS);
                u32x2* ho = (u32x2*)(hout + (size_t)(m + q * NGW) * ldh) + lane;
#pragma unroll
                for (int j = 0; j < 4; ++j) { const f32x4 gp = ((const f32x4*)gpre)[lane + 64 * j]; const f32x4 o = v[q][j] * r * gp; u32x2 w; w.x = pk2(o[0], o[1]); w.y = pk2(o[2], o[3]); ho[64 * j] = w; } }
        }
    }
}

__device__ __forceinline__ void tr_item(const float* W, int ldw, int col0, bf16_t* WT, int ldt, int row0, int nblk, LAS float* scr, int item, int lane) {
    const int kb = item / nblk, nb = item % nblk, k0 = 64 * kb, n0 = 32 * nb;
#pragma unroll
    for (int i = 0; i < 8; ++i) { const int kk = 8 * i + (lane >> 3); const f32x4 v = *(const f32x4*)(W + (size_t)(k0 + kk) * ldw + col0 + n0 + (lane & 7) * 4);
        LAS float* d = scr + kk * 33 + (lane & 7) * 4; d[0] = v[0]; d[1] = v[1]; d[2] = v[2]; d[3] = v[3]; }
    LDS_FENCE();
    const int c = lane & 7;
#pragma unroll
    for (int j = 0; j < 4; ++j) { const int n = (lane >> 3) + 8 * j; const LAS float* s = scr + (8 * c) * 33 + n;
        u32x4 o; o.x = pk2(s[0 * 33], s[1 * 33]); o.y = pk2(s[2 * 33], s[3 * 33]); o.z = pk2(s[4 * 33], s[5 * 33]); o.w = pk2(s[6 * 33], s[7 * 33]);
        *(u32x4*)(WT + (size_t)(row0 + n0 + n) * ldt + k0 + 8 * c) = o; }
    LDS_FENCE();
}
__device__ __forceinline__ int small_src(int i) { return i < 8 ? 1536 + i : (i < 12 ? 3080 + (i - 8) : 3084 + (i - 12)); }
struct LayerW { const float *w_in, *b_in, *w_branch, *w_out, *w_xq, *w_xkv, *w_xo, *w_ff1, *w_ff2; };
__device__ __forceinline__ void convert_weights(const LayerW& L, unsigned char* ws, LAS unsigned char* lds, int gw, int NGW, int wave, int lane, int gtid, int NGT) {
    bf16_t* Win_t = (bf16_t*)(ws + WS_WIN); bf16_t* Wm_t = (bf16_t*)(ws + WS_WM); bf16_t* Wo_t = (bf16_t*)(ws + WS_WO); bf16_t* Wxq_t = (bf16_t*)(ws + WS_WXQ);
    bf16_t* Wxkv_t = (bf16_t*)(ws + WS_WXKV); bf16_t* Wxo_t = (bf16_t*)(ws + WS_WXO); bf16_t* W1_t = (bf16_t*)(ws + WS_W1); bf16_t* W2_t = (bf16_t*)(ws + WS_W2);
    float* biasz = (float*)(ws + WS_BIASZ);
    LAS float* scr = (LAS float*)(lds + wave * 16384);
    constexpr int NIT = 768 + 768 + 256 + 512 + 1536 + 3 * 256 + 512 + 512 + 1024 + 512 + 2048 + 2048;
#pragma unroll 1
    for (int it = gw; it < NIT; it += NGW) {
        int r = it;
        if (r < 768) { tr_item(L.w_in, DIN, 0, Win_t, 1024, 0, 48, scr, r, lane); continue; } r -= 768;
        if (r < 768) { tr_item(L.w_in, DIN, 1544, Win_t, 1024, 1536, 48, scr, r, lane); continue; } r -= 768;
        if (r < 256) { tr_item(L.w_in, DIN, 3088, Win_t, 1024, 3072, 16, scr, r, lane); continue; } r -= 256;
        if (r < 512) { tr_item(L.w_in, DIN, 3600, Win_t, 1024, 3584, 32, scr, r, lane); continue; } r -= 512;
        if (r < 1536) { tr_item(L.w_in, DIN, 4624, Wm_t, 1024, 0, 96, scr, r, lane); continue; } r -= 1536;
        if (r < 768) { const int n = r >> 8; tr_item(L.w_branch + (size_t)n * 512 * 1024, 1024, 0, Wm_t, 1024, 3072 + n * 1024, 32, scr, r & 255, lane); continue; } r -= 768;
        if (r < 512) { tr_item(L.w_out, 1024, 0, Wo_t, 1024, 0, 32, scr, r, lane); continue; } r -= 512;
        if (r < 512) { tr_item(L.w_xq, 1024, 0, Wxq_t, 1024, 0, 32, scr, r, lane); continue; } r -= 512;
        if (r < 1024) { tr_item(L.w_xkv, 2048, 0, Wxkv_t, 1024, 0, 64, scr, r, lane); continue; } r -= 1024;
        if (r < 512) { tr_item(L.w_xo, 1024, 0, Wxo_t, 1024, 0, 32, scr, r, lane); continue; } r -= 512;
        if (r < 2048) { tr_item(L.w_ff1, 4096, 0, W1_t, 1024, 0, 128, scr, r, lane); continue; } r -= 2048;
        tr_item(L.w_ff2, 1024, 0, W2_t, 4096, 0, 32, scr, r, lane);
    }
    const u32x4 z4 = {0u, 0u, 0u, 0u};
#pragma unroll 1
    for (int i = gtid; i < 3072 * 64; i += NGT) { const int row = i >> 6, c = i & 63; *(u32x4*)(Wm_t + (size_t)(3072 + row) * 1024 + 512 + c * 8) = z4; }
#pragma unroll 1
    for (int i = gtid; i < 240 * 128; i += NGT) { const int row = i >> 7, c = i & 127; *(u32x4*)(Win_t + (size_t)(4624 + row) * 1024 + c * 8) = z4; }
#pragma unroll 1
    for (int i = gtid; i < 16 * 1024; i += NGT) { const int j = i >> 10, k = i & 1023; Win_t[(size_t)(4608 + j) * 1024 + k] = f2bf(L.w_in[(size_t)k * DIN + small_src(j)]); }
#pragma unroll 1
    for (int c = gtid; c < 4864; c += NGT) {
        float v;
        if (c < 1536) v = L.b_in[c]; else if (c < 3072) v = L.b_in[1544 + c - 1536]; else if (c < 3584) v = L.b_in[3088 + c - 3072];
        else if (c < 4608) v = L.b_in[3600 + c - 3584]; else if (c < 4624) v = L.b_in[small_src(c - 4608)]; else v = 0.f;
        biasz[c] = v;
    }
}

constexpr float L2E = 1.4426950408889634f;
__device__ __forceinline__ void fox_softmax(f32x4 (&S)[4], float FtL, int qrow, int kt, bool needmask, LAS bf16_t* Ps, int fr, int fq) {
    if (needmask) {
        const int t = qrow + fr;
#pragma unroll
        for (int nt = 0; nt < 4; ++nt)
#pragma unroll
            for (int j = 0; j < 4; ++j) { const int key = kt * 64 + nt * 16 + fq * 4 + j; if (key > t) S[nt][j] = -INFINITY; }
    }
#pragma unroll
    for (int nt = 0; nt < 4; ++nt) {
        const float p0 = __builtin_amdgcn_exp2f(fmaf(S[nt][0], L2E, FtL)), p1 = __builtin_amdgcn_exp2f(fmaf(S[nt][1], L2E, FtL));
        const float p2 = __builtin_amdgcn_exp2f(fmaf(S[nt][2], L2E, FtL)), p3 = __builtin_amdgcn_exp2f(fmaf(S[nt][3], L2E, FtL));
        u32x2 o; o.x = pk2(p0, p1); o.y = pk2(p2, p3);
        *(LAS u32x2*)(Ps + fr * 72 + nt * 16 + fq * 4) = o; }
}
template <bool BOTH>
__device__ __forceinline__ void fox_tile(const LAS bf16_t* Kb, const LAS bf16_t* Vb, const LAS float* NFk, const bf16x8 (&qfA)[2], const bf16x8 (&qfB)[2], float FtLA, float FtLB,
                                         f32x4 (&OA)[5], f32x4 (&OB)[5], int qrowA, int qrowB, int kt, LAS bf16_t* PsA, LAS bf16_t* PsB, int lane, int fr, int fq) {
    f32x4 SA[4], SB[4];
#pragma unroll
    for (int nt = 0; nt < 4; ++nt) { const bf16x8 k0 = frag(Kb, 72, nt * 16, 0, lane), k1 = frag(Kb, 72, nt * 16, 32, lane);
        const f32x4 nf = *(const LAS f32x4*)(NFk + nt * 16 + fq * 4);
        SB[nt] = MFMA16(k0, qfB[0], nf); SB[nt] = MFMA16(k1, qfB[1], SB[nt]);
        if constexpr (BOTH) { SA[nt] = MFMA16(k0, qfA[0], nf); SA[nt] = MFMA16(k1, qfA[1], SA[nt]); } }
    fox_softmax(SB, FtLB, qrowB, kt, kt * 64 + 63 > qrowB, PsB, fr, fq);
    if constexpr (BOTH) fox_softmax(SA, FtLA, qrowA, kt, kt * 64 + 63 > qrowA, PsA, fr, fq);
    LDS_FENCE();
#pragma unroll
    for (int ks = 0; ks < 2; ++ks) { const bf16x8 pB = frag(PsB, 72, 0, ks * 32, lane); bf16x8 pA = pB; if constexpr (BOTH) pA = frag(PsA, 72, 0, ks * 32, lane);
#pragma unroll
        for (int nt = 0; nt < 5; ++nt) { const bf16x8 vf = frag(Vb, 72, nt * 16, ks * 32, lane);
            OB[nt] = MFMA16(vf, pB, OB[nt]); if constexpr (BOTH) OA[nt] = MFMA16(vf, pA, OA[nt]); } }
    LDS_FENCE();
}
__device__ __forceinline__ bf16x8 load_q_scaled(const bf16_t* p) {
    u32x4 r = *(const u32x4*)p;
    r.x = pk2(bf_lo(r.x) * 0.125f, bf_hi(r.x) * 0.125f); r.y = pk2(bf_lo(r.y) * 0.125f, bf_hi(r.y) * 0.125f);
    r.z = pk2(bf_lo(r.z) * 0.125f, bf_hi(r.z) * 0.125f); r.w = pk2(bf_lo(r.w) * 0.125f, bf_hi(r.w) * 0.125f);
    return __builtin_bit_cast(bf16x8, r);
}
__device__ __forceinline__ void fox_item(LAS unsigned char* lds, bf16_t* Z, int b, int h, int p, int tid) {
    asm volatile("" : "+v"(tid));
    const int lane = tid & 63, w = __builtin_amdgcn_readfirstlane(tid >> 6), fr = lane & 15, fq = lane >> 4;
    LAS float* NF = (LAS float*)lds;
    LAS float* wsum = (LAS float*)(lds + 8192);
    LAS bf16_t* Ks = (LAS bf16_t*)(lds + 8448);
    LAS bf16_t* Vt = Ks + 2 * 64 * 72;
    LAS bf16_t* PsA = Vt + 2 * 80 * 72 + w * 32 * 72;
    LAS bf16_t* PsB = PsA + 16 * 72;
    const int qbA = 2 * p, qbB = 2 * p + 1, q1 = (qbB + 1) * 128;
    const size_t rowbase = (size_t)b * SEQ;
    {
        float lf[4]; float run = 0.f;
#pragma unroll
        for (int i = 0; i < 4; ++i) { const int t = 4 * tid + i; float v = 0.f; if (t < q1) v = logsigmoidf_(bf2f(Z[(rowbase + t) * LDZ + ZC_SM + h])); run += v; lf[i] = run; }
        float sc = run;
#pragma unroll
        for (int o = 1; o < 64; o <<= 1) { const float nb = shup(sc, o, lane); if (lane >= o) sc += nb; }
        if (lane == 63) wsum[w] = sc;
        for (int i = tid; i < 2 * 16 * 72; i += 512) { const int bufi = i / (16 * 72), r = i % (16 * 72); Vt[bufi * 80 * 72 + 64 * 72 + r] = (r < 72) ? (bf16_t)0x3F80 : (bf16_t)0; }
        __syncthreads();
        float base = 0.f;
        for (int i = 0; i < w; ++i) base += wsum[i];
        const float excl = base + sc - run;
#pragma unroll
        for (int i = 0; i < 4; ++i) NF[4 * tid + i] = -(excl + lf[i]);
    }
    const int qrowA = qbA * 128 + w * 16, qrowB = qbB * 128 + w * 16;
    bf16x8 qfA[2], qfB[2];
#pragma unroll
    for (int ks = 0; ks < 2; ++ks) { qfA[ks] = load_q_scaled(Z + (rowbase + qrowA + fr) * LDZ + ZC_FQ + h * 64 + ks * 32 + fq * 8);
                                     qfB[ks] = load_q_scaled(Z + (rowbase + qrowB + fr) * LDZ + ZC_FQ + h * 64 + ks * 32 + fq * 8); }
    const bool vrole = tid < 256;
    const int su = tid & 255, skey = su >> 3, sdc = su & 7;
    const bf16_t* sbase = Z + rowbase * LDZ + h * 64 + sdc * 8 + (vrole ? (size_t)ZC_FV + (size_t)(2 * skey) * LDZ : (size_t)ZC_FK + (size_t)skey * LDZ);
    const size_t sstep = vrole ? (size_t)LDZ : (size_t)32 * LDZ;
    u32x4 r0, r1;
#define FOX_LOAD(kt_) do { const bf16_t* s_ = sbase + (size_t)(kt_) * 64 * LDZ; r0 = *(const u32x4*)s_; r1 = *(const u32x4*)(s_ + sstep); } while (0)
#define FOX_STORE(buf_) do { if (vrole) { LAS bf16_t* vp = Vt + (buf_) * 80 * 72 + (sdc * 8) * 72 + 2 * skey; \
        *(LAS unsigned*)(vp + 0 * 72) = (r0.x & 0xffffu) | (r1.x << 16); *(LAS unsigned*)(vp + 1 * 72) = (r0.x >> 16) | (r1.x & 0xffff0000u); \
        *(LAS unsigned*)(vp + 2 * 72) = (r0.y & 0xffffu) | (r1.y << 16); *(LAS unsigned*)(vp + 3 * 72) = (r0.y >> 16) | (r1.y & 0xffff0000u); \
        *(LAS unsigned*)(vp + 4 * 72) = (r0.z & 0xffffu) | (r1.z << 16); *(LAS unsigned*)(vp + 5 * 72) = (r0.z >> 16) | (r1.z & 0xffff0000u); \
        *(LAS unsigned*)(vp + 6 * 72) = (r0.w & 0xffffu) | (r1.w << 16); *(LAS unsigned*)(vp + 7 * 72) = (r0.w >> 16) | (r1.w & 0xffff0000u); } \
      else { *(LAS u32x4*)(Ks + (buf_) * 64 * 72 + skey * 72 + sdc * 8) = r0; *(LAS u32x4*)(Ks + (buf_) * 64 * 72 + (skey + 32) * 72 + sdc * 8) = r1; } } while (0)
    const int nkt = q1 / 64;
    FOX_LOAD(0); FOX_STORE(0); FOX_LOAD(1);
    __syncthreads();
    const float FtLA = -NF[qrowA + fr] * L2E, FtLB = -NF[qrowB + fr] * L2E;
    f32x4 OA[5], OB[5];
#pragma unroll
    for (int nt = 0; nt < 5; ++nt) { OA[nt] = (f32x4){0.f, 0.f, 0.f, 0.f}; OB[nt] = (f32x4){0.f, 0.f, 0.f, 0.f}; }
    for (int kt = 0; kt < nkt; ++kt) {
        const int buf = kt & 1;
        if (kt + 1 < nkt) { FOX_STORE(buf ^ 1); if (kt + 2 < nkt) FOX_LOAD(kt + 2); }
        const bool actB = kt * 64 <= qrowB + 15, actA = kt * 64 <= qrowA + 15;
        if (actB) {
            const LAS bf16_t* Kb = Ks + buf * 64 * 72; const LAS bf16_t* Vb = Vt + buf * 80 * 72;
            if (actA) fox_tile<true>(Kb, Vb, NF + kt * 64, qfA, qfB, FtLA, FtLB, OA, OB, qrowA, qrowB, kt, PsA, PsB, lane, fr, fq);
            else fox_tile<false>(Kb, Vb, NF + kt * 64, qfA, qfB, FtLA, FtLB, OA, OB, qrowA, qrowB, kt, PsA, PsB, lane, fr, fq);
        }
        __syncthreads();
    }
#undef FOX_LOAD
#undef FOX_STORE
    {
        const float iA = 1.f / shidx(OA[4][0], fr), iB = 1.f / shidx(OB[4][0], fr);
        bf16_t* pa = Z + (rowbase + qrowA + fr) * LDZ + ZC_FQ + h * 64 + fq * 4; bf16_t* pb = Z + (rowbase + qrowB + fr) * LDZ + ZC_FQ + h * 64 + fq * 4;
#pragma unroll
        for (int nt = 0; nt < 4; ++nt) { u32x2 o;
            o.x = pk2(OA[nt][0] * iA, OA[nt][1] * iA); o.y = pk2(OA[nt][2] * iA, OA[nt][3] * iA); *(u32x2*)(pa + nt * 16) = o;
            o.x = pk2(OB[nt][0] * iB, OB[nt][1] * iB); o.y = pk2(OB[nt][2] * iB, OB[nt][3] * iB); *(u32x2*)(pb + nt * 16) = o; } }
    __syncthreads();
}

__device__ __forceinline__ void mlstm_item(LAS unsigned char* lds, bf16_t* Z, const float* convw, const float* mg, int b, int h, int tid) {
    asm volatile("" : "+v"(tid));
    const int lane = tid & 63, w = __builtin_amdgcn_readfirstlane(tid >> 6), fr = lane & 15, fq = lane >> 4;
    LAS bf16_t* Qs = (LAS bf16_t*)lds;
    LAS bf16_t* Ks = Qs + 64 * 136;
    LAS bf16_t* KWt = Ks + 64 * 136;
    LAS bf16_t* Vt = KWt + 128 * 72;
    LAS bf16_t* Ct = Vt + 144 * 72;
    LAS bf16_t* Ps = Ct + 144 * 136;
    LAS float* GA = (LAS float*)(Ps + 64 * 72);
    LAS float* GM = GA + 64; LAS float* WI = GA + 128; LAS float* EN = GA + 192; LAS float* WS = GA + 256; LAS float* SC = GA + 320;
    LAS float* SSQ = GA + 336;
    LAS float* CW = GA + 464;
    LAS float* MGs = GA + 1488;
    const size_t rowbase = (size_t)b * SEQ;
    for (int i = tid; i < 144 * 136 / 2; i += 512) ((LAS unsigned*)Ct)[i] = 0u;
    for (int i = tid; i < 16 * 72; i += 512) Vt[128 * 72 + i] = (i < 72) ? (bf16_t)0x3F80 : (bf16_t)0;
    for (int i = tid; i < 1024; i += 512) { const int j = i >> 8, c = i & 255; CW[i] = convw[j * 1024 + (c < 128 ? h * 128 + c : 512 + h * 128 + (c - 128))]; }
    if (tid < 128) MGs[tid] = mg[h * 128 + tid];
    f32x4 Cacc[9];
#pragma unroll
    for (int nt = 0; nt < 9; ++nt) Cacc[nt] = (f32x4){0.f, 0.f, 0.f, 0.f};
    float mprev = 0.f;
    const int role = __builtin_amdgcn_readfirstlane(tid >> 8);
    const int su = tid & 255, tq = su >> 4, dc = su & 15;
    const int vt2 = tid >> 4, dcv = tid & 15;
    const int mt_t = w & 3, half = w >> 2, tl = mt_t * 16 + fr;
    const bf16_t* qkbase = Z + rowbase * LDZ + (role ? ZC_MK : ZC_MQ) + h * 128 + dc * 8;
    const bf16_t* vbase = Z + (rowbase + 2 * vt2) * LDZ + ZC_MV + h * 128 + dcv * 8;
    u32x4 rq[7], rv[2]; float gi = 0.f, gf = 0.f;
#define ML_LOAD(ch_) do { const int t0_ = (ch_) * 64; \
        _Pragma("unroll") for (int i = 0; i < 7; ++i) { const int tg = t0_ + 4 * tq - 3 + i; rq[i] = (u32x4){0u, 0u, 0u, 0u}; if (tg >= 0) rq[i] = *(const u32x4*)(qkbase + (size_t)tg * LDZ); } \
        rv[0] = *(const u32x4*)(vbase + (size_t)t0_ * LDZ); rv[1] = *(const u32x4*)(vbase + (size_t)(t0_ + 1) * LDZ); \
        if (w == 0) { const size_t row = rowbase + t0_ + lane; gi = bf2f(Z[row * LDZ + ZC_SM + 8 + h]); gf = bf2f(Z[row * LDZ + ZC_SM + 12 + h]); } } while (0)
    ML_LOAD(0);
    for (int ch = 0; ch < SEQ / 64; ++ch) {
        const int t0 = ch * 64;
        if (w == 0) {
            float bc = logsigmoidf_(gf);
#pragma unroll
            for (int o = 1; o < 64; o <<= 1) { const float nb = shup(bc, o, lane); if (lane >= o) bc += nb; }
            const float av = gi - bc;
            float gm = av;
#pragma unroll
            for (int o = 1; o < 64; o <<= 1) { const float nb = shup(gm, o, lane); if (lane >= o) gm = fmaxf(gm, nb); }
            const float mm = fmaxf(mprev, gm), mt = bc + mm;
            GA[lane] = av; GM[lane] = mm; WI[lane] = __expf(mprev - mm); EN[lane] = __expf(-mt);
            const float mm63 = shidx(mm, 63), b63 = shidx(bc, 63);
            WS[lane] = __expf(av - mm63);
            if (lane == 0) SC[0] = __expf(mprev - mm63);
            mprev = b63 + mm63;
        }
        __syncthreads();
        {
            u32x4 okp[4];
#pragma unroll
            for (int a = 0; a < 4; ++a) {
                float acc[8];
#pragma unroll
                for (int e = 0; e < 8; ++e) acc[e] = 0.f;
#pragma unroll
                for (int j = 0; j < 4; ++j) { const u32x4 r = rq[a + j];
                    const f32x4 c0 = *(const LAS f32x4*)(CW + j * 256 + role * 128 + dc * 8), c1 = *(const LAS f32x4*)(CW + j * 256 + role * 128 + dc * 8 + 4);
                    acc[0] += c0[0] * bf_lo(r.x); acc[1] += c0[1] * bf_hi(r.x); acc[2] += c0[2] * bf_lo(r.y); acc[3] += c0[3] * bf_hi(r.y);
                    acc[4] += c1[0] * bf_lo(r.z); acc[5] += c1[1] * bf_hi(r.z); acc[6] += c1[2] * bf_lo(r.w); acc[7] += c1[3] * bf_hi(r.w); }
                const float sc_ = role ? 0.08838834764831845f : 1.f;
#pragma unroll
                for (int e = 0; e < 8; ++e) acc[e] = acc[e] * sigmoidf_(acc[e]) * sc_;
                u32x4 o; o.x = pk2(acc[0], acc[1]); o.y = pk2(acc[2], acc[3]); o.z = pk2(acc[4], acc[5]); o.w = pk2(acc[6], acc[7]);
                *(LAS u32x4*)((role ? Ks : Qs) + (4 * tq + a) * 136 + dc * 8) = o;
                okp[a] = o;
                asm volatile("" ::: "memory");
            }
            if (role == 1) {
                const float w0 = WS[4 * tq], w1 = WS[4 * tq + 1], w2 = WS[4 * tq + 2], w3 = WS[4 * tq + 3];
                LAS bf16_t* kp = KWt + (dc * 8) * 72 + 4 * tq;
                u32x2 o;
                o.x = pk2(bf_lo(okp[0].x) * w0, bf_lo(okp[1].x) * w1); o.y = pk2(bf_lo(okp[2].x) * w2, bf_lo(okp[3].x) * w3); *(LAS u32x2*)(kp + 0 * 72) = o;
                o.x = pk2(bf_hi(okp[0].x) * w0, bf_hi(okp[1].x) * w1); o.y = pk2(bf_hi(okp[2].x) * w2, bf_hi(okp[3].x) * w3); *(LAS u32x2*)(kp + 1 * 72) = o;
                o.x = pk2(bf_lo(okp[0].y) * w0, bf_lo(okp[1].y) * w1); o.y = pk2(bf_lo(okp[2].y) * w2, bf_lo(okp[3].y) * w3); *(LAS u32x2*)(kp + 2 * 72) = o;
                o.x = pk2(bf_hi(okp[0].y) * w0, bf_hi(okp[1].y) * w1); o.y = pk2(bf_hi(okp[2].y) * w2, bf_hi(okp[3].y) * w3); *(LAS u32x2*)(kp + 3 * 72) = o;
                o.x = pk2(bf_lo(okp[0].z) * w0, bf_lo(okp[1].z) * w1); o.y = pk2(bf_lo(okp[2].z) * w2, bf_lo(okp[3].z) * w3); *(LAS u32x2*)(kp + 4 * 72) = o;
                o.x = pk2(bf_hi(okp[0].z) * w0, bf_hi(okp[1].z) * w1); o.y = pk2(bf_hi(okp[2].z) * w2, bf_hi(okp[3].z) * w3); *(LAS u32x2*)(kp + 5 * 72) = o;
                o.x = pk2(bf_lo(okp[0].w) * w0, bf_lo(okp[1].w) * w1); o.y = pk2(bf_lo(okp[2].w) * w2, bf_lo(okp[3].w) * w3); *(LAS u32x2*)(kp + 6 * 72) = o;
                o.x = pk2(bf_hi(okp[0].w) * w0, bf_hi(okp[1].w) * w1); o.y = pk2(bf_hi(okp[2].w) * w2, bf_hi(okp[3].w) * w3); *(LAS u32x2*)(kp + 7 * 72) = o;
            }
            LAS bf16_t* vp = Vt + (dcv * 8) * 72 + 2 * vt2;
            *(LAS unsigned*)(vp + 0 * 72) = (rv[0].x & 0xffffu) | (rv[1].x << 16); *(LAS unsigned*)(vp + 1 * 72) = (rv[0].x >> 16) | (rv[1].x & 0xffff0000u);
            *(LAS unsigned*)(vp + 2 * 72) = (rv[0].y & 0xffffu) | (rv[1].y << 16); *(LAS unsigned*)(vp + 3 * 72) = (rv[0].y >> 16) | (rv[1].y & 0xffff0000u);
            *(LAS unsigned*)(vp + 4 * 72) = (rv[0].z & 0xffffu) | (rv[1].z << 16); *(LAS unsigned*)(vp + 5 * 72) = (rv[0].z >> 16) | (rv[1].z & 0xffff0000u);
            *(LAS unsigned*)(vp + 6 * 72) = (rv[0].w & 0xffffu) | (rv[1].w << 16); *(LAS unsigned*)(vp + 7 * 72) = (rv[0].w >> 16) | (rv[1].w & 0xffff0000u);
        }
        u32x2 mo[4];
        bf16_t* orow = Z + (rowbase + t0 + tl) * LDZ + ZC_MO + h * 128 + half * 64 + fq * 4;
#pragma unroll
        for (int x = 0; x < 4; ++x) mo[x] = *(const u32x2*)(orow + x * 16);
        if (ch + 1 < SEQ / 64) ML_LOAD(ch + 1);
        __syncthreads();
        {   const int mt = w >> 1;
#pragma unroll
            for (int x = 0; x < 2; ++x) { const int nt = (w & 1) * 2 + x;
                f32x4 acc = (f32x4){0.f, 0.f, 0.f, 0.f};
#pragma unroll
                for (int ks = 0; ks < 4; ++ks) acc = MFMA16(frag(Qs, 136, mt * 16, ks * 32, lane), frag(Ks, 136, nt * 16, ks * 32, lane), acc);
                const int s = nt * 16 + fr; const float as = GA[s];
#pragma unroll
                for (int j = 0; j < 4; ++j) { const int t = mt * 16 + fq * 4 + j; const float pv = (s <= t) ? acc[j] * __expf(as - GM[t]) : 0.f; Ps[t * 72 + s] = f2bf(pv); }
            }
        }
        __syncthreads();
        {
            bf16x8 qfr[4], pfr[2];
#pragma unroll
            for (int ks = 0; ks < 4; ++ks) qfr[ks] = frag(Qs, 136, mt_t * 16, ks * 32, lane);
#pragma unroll
            for (int ks = 0; ks < 2; ++ks) pfr[ks] = frag(Ps, 72, mt_t * 16, ks * 32, lane);
            const float wi = WI[tl];
            f32x4 Hacc[5];
#pragma unroll
            for (int x = 0; x < 5; ++x) { const int me = (x < 4) ? half * 4 + x : 8;
                f32x4 acc = (f32x4){0.f, 0.f, 0.f, 0.f};
#pragma unroll
                for (int ks = 0; ks < 4; ++ks) acc = MFMA16(frag(Ct, 136, me * 16, ks * 32, lane), qfr[ks], acc);
                acc = acc * wi;
#pragma unroll
                for (int ks = 0; ks < 2; ++ks) acc = MFMA16(frag(Vt, 72, me * 16, ks * 32, lane), pfr[ks], acc);
                Hacc[x] = acc; }
            const float den = shidx(Hacc[4][0], fr);
            const float inv = 1.f / fmaxf(fabsf(den), EN[tl]);
            float s = 0.f;
#pragma unroll
            for (int x = 0; x < 4; ++x) { Hacc[x] = Hacc[x] * inv; s += (Hacc[x][0] * Hacc[x][0] + Hacc[x][1] * Hacc[x][1]) + (Hacc[x][2] * Hacc[x][2] + Hacc[x][3] * Hacc[x][3]); }
            s += shx(s, 16, lane); s += shx(s, 32, lane);
            if (fq == 0) SSQ[half * 64 + tl] = s;
            __syncthreads();
            const float r = frsq((SSQ[tl] + SSQ[64 + tl]) * (1.f / 128.f) + EPS);
#pragma unroll
            for (int x = 0; x < 4; ++x) { const f32x4 g4 = *(const LAS f32x4*)(MGs + half * 64 + x * 16 + fq * 4);
                u32x2 o;
                o.x = pk2(sigmoidf_(bf_lo(mo[x].x)) * Hacc[x][0] * r * g4[0], sigmoidf_(bf_hi(mo[x].x)) * Hacc[x][1] * r * g4[1]);
                o.y = pk2(sigmoidf_(bf_lo(mo[x].y)) * Hacc[x][2] * r * g4[2], sigmoidf_(bf_hi(mo[x].y)) * Hacc[x][3] * r * g4[3]);
                *(u32x2*)(orow + x * 16) = o; }
        }
        {   const float decay = SC[0];
#pragma unroll
            for (int nt = 0; nt < 9; ++nt) Cacc[nt] = Cacc[nt] * decay;
#pragma unroll
            for (int ks = 0; ks < 2; ++ks) { const bf16x8 af = frag(KWt, 72, w * 16, ks * 32, lane);
#pragma unroll
                for (int nt = 0; nt < 9; ++nt) Cacc[nt] = MFMA16(af, frag(Vt, 72, nt * 16, ks * 32, lane), Cacc[nt]); }
#pragma unroll
            for (int nt = 0; nt < 9; ++nt) { u32x2 o; o.x = pk2(Cacc[nt][0], Cacc[nt][1]); o.y = pk2(Cacc[nt][2], Cacc[nt][3]);
                *(LAS u32x2*)(Ct + (nt * 16 + fr) * 136 + w * 16 + fq * 4) = o; }
        }
        __syncthreads();
    }
#undef ML_LOAD
}

__device__ __forceinline__ void gmlp_item(LAS unsigned char* lds, bf16_t* Z, const float* gnorm, const float* gws, const float* gbs, int b, int sp, int tid) {
    asm volatile("" : "+v"(tid));
    const int lane = tid & 63, w = __builtin_amdgcn_readfirstlane(tid >> 6), fr = lane & 15, fq = lane >> 4;
    LAS bf16_t* As = (LAS bf16_t*)lds;
    LAS bf16_t* Vt = As + 128 * 136;
    LAS float* ST = (LAS float*)(Vt + 128 * 136);
    const size_t rowbase = (size_t)b * SEQ + sp * 128;
#pragma unroll 1
    for (int tb = 0; tb < 2; ++tb) {
        u32x4 rawv[8];
#pragma unroll
        for (int i = 0; i < 8; ++i) rawv[i] = *(const u32x4*)(Z + (rowbase + w * 16 + tb * 8 + i) * LDZ + ZC_GV + lane * 8);
        float s[8], q[8];
#pragma unroll
        for (int i = 0; i < 8; ++i) { const u32x4 raw = rawv[i];
            float x[8]; x[0] = bf_lo(raw.x); x[1] = bf_hi(raw.x); x[2] = bf_lo(raw.y); x[3] = bf_hi(raw.y); x[4] = bf_lo(raw.z); x[5] = bf_hi(raw.z); x[6] = bf_lo(raw.w); x[7] = bf_hi(raw.w);
            s[i] = 0.f; q[i] = 0.f;
#pragma unroll
            for (int e = 0; e < 8; ++e) { const float gx = gelu_tanh(x[e]); s[i] += gx; q[i] += gx * gx; } }
#pragma unroll
        for (int o = 1; o < 64; o <<= 1) {
#pragma unroll
            for (int i = 0; i < 8; ++i) { s[i] += shx(s[i], o, lane); q[i] += shx(q[i], o, lane); } }
        if (lane < 8) {
            float sv = s[0], qv = q[0];
#pragma unroll
            for (int i = 1; i < 8; ++i) { if (lane == i) { sv = s[i]; qv = q[i]; } }
            const float mean = sv * (1.f / 512.f); const float var = fmaxf(qv * (1.f / 512.f) - mean * mean, 0.f);
            const int t = w * 16 + tb * 8 + lane; ST[2 * t] = mean; ST[2 * t + 1] = frsq(var + EPS);
        }
    }
    __syncthreads();
#pragma unroll 1
    for (int g = 0; g < 4; ++g) {
        const float* wsg = gws + (size_t)g * 128 * 128; const float* bsg = gbs + g * 128;
#pragma unroll
        for (int i = 0; i < 8; ++i) { const int idx = tid + 512 * i; const int t = idx >> 5, s4 = (idx & 31) * 4;
            f32x4 wv = *(const f32x4*)(wsg + t * 128 + s4); if ((t >> 6) < (s4 >> 6)) wv = (f32x4){0.f, 0.f, 0.f, 0.f};
            u32x2 o; o.x = pk2(wv[0], wv[1]); o.y = pk2(wv[2], wv[3]); *(LAS u32x2*)(As + t * 136 + s4) = o; }
#pragma unroll
        for (int i = 0; i < 2; ++i) { const int u = tid + 512 * i; const int tp = u >> 4, dcg = u & 15;
            const bf16_t* src0 = Z + (rowbase + 2 * tp) * LDZ + ZC_GV + g * 128 + dcg * 8;
            const u32x4 ra = *(const u32x4*)src0, rb = *(const u32x4*)(src0 + LDZ);
            const float m0 = ST[4 * tp], r0 = ST[4 * tp + 1], m1 = ST[4 * tp + 2], r1 = ST[4 * tp + 3];
            const f32x4 g0 = *(const f32x4*)(gnorm + g * 128 + dcg * 8), g1 = *(const f32x4*)(gnorm + g * 128 + dcg * 8 + 4);
            LAS bf16_t* vp = Vt + (dcg * 8) * 136 + 2 * tp;
            *(LAS unsigned*)(vp + 0 * 136) = pk2((gelu_tanh(bf_lo(ra.x)) - m0) * r0 * g0[0], (gelu_tanh(bf_lo(rb.x)) - m1) * r1 * g0[0]);
            *(LAS unsigned*)(vp + 1 * 136) = pk2((gelu_tanh(bf_hi(ra.x)) - m0) * r0 * g0[1], (gelu_tanh(bf_hi(rb.x)) - m1) * r1 * g0[1]);
            *(LAS unsigned*)(vp + 2 * 136) = pk2((gelu_tanh(bf_lo(ra.y)) - m0) * r0 * g0[2], (gelu_tanh(bf_lo(rb.y)) - m1) * r1 * g0[2]);
            *(LAS unsigned*)(vp + 3 * 136) = pk2((gelu_tanh(bf_hi(ra.y)) - m0) * r0 * g0[3], (gelu_tanh(bf_hi(rb.y)) - m1) * r1 * g0[3]);
            *(LAS unsigned*)(vp + 4 * 136) = pk2((gelu_tanh(bf_lo(ra.z)) - m0) * r0 * g1[0], (gelu_tanh(bf_lo(rb.z)) - m1) * r1 * g1[0]);
            *(LAS unsigned*)(vp + 5 * 136) = pk2((gelu_tanh(bf_hi(ra.z)) - m0) * r0 * g1[1], (gelu_tanh(bf_hi(rb.z)) - m1) * r1 * g1[1]);
            *(LAS unsigned*)(vp + 6 * 136) = pk2((gelu_tanh(bf_lo(ra.w)) - m0) * r0 * g1[2], (gelu_tanh(bf_lo(rb.w)) - m1) * r1 * g1[2]);
            *(LAS unsigned*)(vp + 7 * 136) = pk2((gelu_tanh(bf_hi(ra.w)) - m0) * r0 * g1[3], (gelu_tanh(bf_hi(rb.w)) - m1) * r1 * g1[3]);
        }
        __syncthreads();
        f32x4 acc[8];
#pragma unroll
        for (int mt = 0; mt < 8; ++mt) acc[mt] = (f32x4){0.f, 0.f, 0.f, 0.f};
        const int kmax = (w < 4) ? 2 : 4;
        for (int ks = 0; ks < kmax; ++ks) { const bf16x8 bfr = frag(As, 136, w * 16, ks * 32, lane);
#pragma unroll
            for (int mt = 0; mt < 8; ++mt) acc[mt] = MFMA16(frag(Vt, 136, mt * 16, ks * 32, lane), bfr, acc[mt]); }
        {   const int t = w * 16 + fr; const float bt = bsg[t];
            bf16_t* rowp = Z + (rowbase + t) * LDZ + ZC_GU + g * 128 + fq * 4;
            u32x2 uu[8];
#pragma unroll
            for (int mt = 0; mt < 8; ++mt) uu[mt] = *(const u32x2*)(rowp + mt * 16);
#pragma unroll
            for (int mt = 0; mt < 8; ++mt) { u32x2 o;
                o.x = pk2(gelu_tanh(bf_lo(uu[mt].x)) * (acc[mt][0] + bt), gelu_tanh(bf_hi(uu[mt].x)) * (acc[mt][1] + bt));
                o.y = pk2(gelu_tanh(bf_lo(uu[mt].y)) * (acc[mt][2] + bt), gelu_tanh(bf_hi(uu[mt].y)) * (acc[mt][3] + bt));
                *(u32x2*)(rowp + mt * 16) = o; } }
        __syncthreads();
    }
}

__device__ __forceinline__ void xattn_item(LAS unsigned char* lds, const bf16_t* Q, const bf16_t* KB, const bf16_t* VT, bf16_t* Oo, int b, int h, int qb, int tid) {
    asm volatile("" : "+v"(tid));
    const int lane = tid & 63, w = __builtin_amdgcn_readfirstlane(tid >> 6), fr = lane & 15, fq = lane >> 4;
    LAS bf16_t* Ks = (LAS bf16_t*)lds;
    LAS bf16_t* Vt = Ks + 64 * 264;
    LAS bf16_t* Ps = Vt + 256 * 72 + w * 16 * 264;
    const size_t qrow = (size_t)b * SEQ + qb * 128 + w * 16;
    bf16x8 qf[8];
#pragma unroll
    for (int ks = 0; ks < 8; ++ks) qf[ks] = *(const bf16x8*)(Q + (qrow + fr) * D + h * 256 + ks * 32 + fq * 8);
    u32x4 pre[4];
    const bf16_t* kbase = KB + (size_t)(b * 256 + (tid >> 5)) * 1024 + h * 256 + (tid & 31) * 8;
    const bf16_t* vbase = VT + ((size_t)(b * 1024 + h * 256 + (tid >> 3))) * 256 + (tid & 7) * 8;
#pragma unroll
    for (int i = 0; i < 4; ++i) pre[i] = *(const u32x4*)(kbase + (size_t)(16 * i) * 1024);
    f32x4 S[16];
#pragma unroll
    for (int kc = 0; kc < 4; ++kc) {
        __syncthreads();
#pragma unroll
        for (int i = 0; i < 4; ++i) *(LAS u32x4*)(Ks + ((tid >> 5) + 16 * i) * 264 + (tid & 31) * 8) = pre[i];
        if (kc < 3) {
#pragma unroll
            for (int i = 0; i < 4; ++i) pre[i] = *(const u32x4*)(kbase + (size_t)((kc + 1) * 64 + 16 * i) * 1024);
        } else {
#pragma unroll
            for (int i = 0; i < 4; ++i) pre[i] = *(const u32x4*)(vbase + (size_t)(64 * i) * 256);
        }
        __syncthreads();
#pragma unroll
        for (int nt = 0; nt < 4; ++nt) { f32x4 acc = (f32x4){0.f, 0.f, 0.f, 0.f};
#pragma unroll
            for (int ks = 0; ks < 8; ++ks) acc = MFMA16(qf[ks], frag(Ks, 264, nt * 16, ks * 32, lane), acc);
            S[kc * 4 + nt] = acc; }
    }
    float inv[4];
#pragma unroll
    for (int j = 0; j < 4; ++j) {
        float mx = -INFINITY;
#pragma unroll
        for (int i = 0; i < 16; ++i) mx = fmaxf(mx, S[i][j]);
        mx = fmaxf(mx, shx(mx, 1, lane)); mx = fmaxf(mx, shx(mx, 2, lane)); mx = fmaxf(mx, shx(mx, 4, lane)); mx = fmaxf(mx, shx(mx, 8, lane));
        float sum = 0.f;
#pragma unroll
        for (int i = 0; i < 16; ++i) { const float p = __expf((S[i][j] - mx) * 0.0625f); sum += p; Ps[(fq * 4 + j) * 264 + i * 16 + fr] = f2bf(p); }
        sum += shx(sum, 1, lane); sum += shx(sum, 2, lane); sum += shx(sum, 4, lane); sum += shx(sum, 8, lane);
        inv[j] = 1.f / sum;
    }
    float invq;
    {   const int srcl = (fr >> 2) * 16;
        const float i0 = shidx(inv[0], srcl), i1 = shidx(inv[1], srcl), i2 = shidx(inv[2], srcl), i3 = shidx(inv[3], srcl);
        invq = (fr & 3) == 0 ? i0 : ((fr & 3) == 1 ? i1 : ((fr & 3) == 2 ? i2 : i3)); }
    f32x4 O[16];
#pragma unroll
    for (int nt = 0; nt < 16; ++nt) O[nt] = (f32x4){0.f, 0.f, 0.f, 0.f};
#pragma unroll
    for (int kc = 0; kc < 4; ++kc) {
        __syncthreads();
#pragma unroll
        for (int i = 0; i < 4; ++i) *(LAS u32x4*)(Vt + ((tid >> 3) + 64 * i) * 72 + (tid & 7) * 8) = pre[i];
        if (kc < 3) {
#pragma unroll
            for (int i = 0; i < 4; ++i) pre[i] = *(const u32x4*)(vbase + (size_t)(64 * i) * 256 + (kc + 1) * 64);
        }
        __syncthreads();
#pragma unroll
        for (int ks = 0; ks < 2; ++ks) { const bf16x8 pf = frag(Ps, 264, 0, kc * 64 + ks * 32, lane);
#pragma unroll
            for (int nt = 0; nt < 16; ++nt) O[nt] = MFMA16(frag(Vt, 72, nt * 16, ks * 32, lane), pf, O[nt]); }
    }
    bf16_t* op = Oo + (qrow + fr) * D + h * 256 + fq * 4;
#pragma unroll
    for (int nt = 0; nt < 16; ++nt) { u32x2 o; o.x = pk2(O[nt][0] * invq, O[nt][1] * invq); o.y = pk2(O[nt][2] * invq, O[nt][3] * invq); *(u32x2*)(op + nt * 16) = o; }
    __syncthreads();
}

#define XB_TMO      128
#define XB_XCNT(j)  (256  + 64 * (j))
#define XB_XSUB(j)  (1280 + 64 * (j))
#define XB_XGEN(j)  (2304 + 64 * (j))
#define XB_TOP      3328
#define XB_TOPGEN   3392
#define XCD_BAR_WORDS 3456
#define XB_SPIN_CAP (1u << 18)

__device__ __forceinline__ unsigned xb_ld(unsigned* p)              { return __hip_atomic_load(p, __ATOMIC_RELAXED, __HIP_MEMORY_SCOPE_AGENT); }
__device__ __forceinline__ unsigned xb_add(unsigned* p, unsigned v) { return __hip_atomic_fetch_add(p, v, __ATOMIC_RELAXED, __HIP_MEMORY_SCOPE_AGENT); }
__device__ __forceinline__ unsigned xb_xcc_id() { return (unsigned)__builtin_amdgcn_s_getreg((3 << 11) | 20) & 0xFu; }
#define XB_SPIN(cond, bar) do { unsigned _sp = 0; while (cond) { __builtin_amdgcn_s_sleep(1); \
    if ((++_sp & 255u) == 0u) { if (xb_ld(&(bar)[XB_TMO])) break; if (_sp > XB_SPIN_CAP) { atomicAdd(&(bar)[XB_TMO], 1u); break; } } } } while (0)

struct XcdBarrier {
    unsigned* bar; unsigned x;
    volatile LAS unsigned* st;
};

__device__ __forceinline__ XcdBarrier xcd_barrier_post(unsigned* bar, volatile LAS unsigned* st) {
    XcdBarrier b; b.bar = bar; b.x = xb_xcc_id(); b.st = st;
    if (threadIdx.x == 0) (void)xb_add(&bar[XB_XCNT(b.x)], 1u);
    return b;
}
__device__ __forceinline__ void xcd_barrier_complete(unsigned* bar, unsigned x, unsigned& nloc, unsigned& nx) {
    const unsigned G = gridDim.x * gridDim.y * gridDim.z;
    unsigned sum, cnt, mine, sp = 0u;
    for (;;) {
        sum = 0u; cnt = 0u; mine = 0u;
#pragma unroll
        for (unsigned j = 0; j < 16; ++j) { const unsigned c = xb_ld(&bar[XB_XCNT(j)]); sum += c; cnt += (c > 0u) ? 1u : 0u; mine = (j == x) ? c : mine; }
        if (sum == G) break;
        __builtin_amdgcn_s_sleep(1);
        if ((++sp & 255u) == 0u) { if (xb_ld(&bar[XB_TMO])) break; if (sp > XB_SPIN_CAP) { atomicAdd(&bar[XB_TMO], 1u); break; } }
    }
    nloc = mine > 0u ? mine : 1u; nx = cnt > 0u ? cnt : 1u;
}

__device__ __forceinline__ void xcd_barrier(const XcdBarrier& b) {
    asm volatile("s_waitcnt vmcnt(0)" ::: "memory");
    __syncthreads();
    if (threadIdx.x == 0) {
        unsigned* bar = b.bar;
        __builtin_amdgcn_s_waitcnt(0);
        unsigned nloc = b.st[0], nx = b.st[1];
        if (nloc == 0u) { xcd_barrier_complete(bar, b.x, nloc, nx); b.st[0] = nloc; b.st[1] = nx; }
        const unsigned old = xb_add(&bar[XB_XSUB(b.x)], 1u);
        const unsigned gen = old / nloc;
        if (old + 1u == (gen + 1u) * nloc) {
            __builtin_amdgcn_fence(__ATOMIC_RELEASE, "agent");
            asm volatile("s_waitcnt vmcnt(0)" ::: "memory");
            const unsigned og = xb_add(&bar[XB_TOP], 1u);
            const unsigned tg = og / nx;
            if (og + 1u == (tg + 1u) * nx) xb_add(&bar[XB_TOPGEN], 1u);
            else XB_SPIN(xb_ld(&bar[XB_TOPGEN]) == tg, bar);
            __builtin_amdgcn_fence(__ATOMIC_ACQUIRE, "agent");
            xb_add(&bar[XB_XGEN(b.x)], 1u);
            asm volatile("s_waitcnt vmcnt(0)" ::: "memory");
        } else {
            XB_SPIN(xb_ld(&bar[XB_XGEN(b.x)]) == gen, bar);
            __builtin_amdgcn_fence(__ATOMIC_ACQUIRE, "agent");
            asm volatile("s_waitcnt vmcnt(0)" ::: "memory");
        }
    }
    __syncthreads();
}


struct Args { const float* in[17]; float* out; unsigned char* ws; int ph_lo, ph_hi; };
__global__ void __launch_bounds__(512, 2) fwd_kernel(Args a) {
    extern __shared__ __attribute__((aligned(16))) unsigned char lds_raw[];
    LAS unsigned char* lds = (LAS unsigned char*)lds_raw;
    constexpr int G = 256; const int bx = blockIdx.x;
    cg::grid_group grid = cg::this_grid();
    {   volatile LAS unsigned* st0 = (volatile LAS unsigned*)(lds + LDS_BYTES - 32);
        if (threadIdx.x < 2) st0[threadIdx.x] = 0u;
        __syncthreads(); }
#if MK_MULTI
    const XcdBarrier xbar = xcd_barrier_post((unsigned*)(a.ws + WS_CTL) + 1024, (volatile LAS unsigned*)(lds + LDS_BYTES - 32));
#else
    if (bx == 0) { u32x4* cz = (u32x4*)(a.ws + WS_CTL);
#pragma unroll
        for (int i = 0; i < 4; ++i) cz[threadIdx.x + 512 * i] = (u32x4){0u, 0u, 0u, 0u}; }
    XcdBarrier xbar; xbar.bar = (unsigned*)(a.ws + WS_CTL) + 1024; xbar.x = xb_xcc_id(); xbar.st = (volatile LAS unsigned*)(lds + LDS_BYTES - 32);
#endif
    const int wave0 = __builtin_amdgcn_readfirstlane((int)threadIdx.x >> 6);
    for (int ph = a.ph_lo; ph < a.ph_hi; ++ph) {
    if (ph != a.ph_lo) {
        if (ph == a.ph_lo + 1) { grid.sync();
#if !MK_MULTI
            if (threadIdx.x == 0) (void)xb_add(&xbar.bar[XB_XCNT(xbar.x)], 1u);
#endif
        } else xcd_barrier(xbar); }
    int tid; asm volatile("v_mbcnt_lo_u32_b32 %0, -1, 0\n\tv_mbcnt_hi_u32_b32 %0, -1, %0" : "=v"(tid)); tid += wave0 * 64;
    unsigned char* ws = a.ws;
    if (PROF_LO >= 0 && bx == 0 && tid == 0) {
        if (ph == PROF_LO && PROF_LO != 98) ((unsigned long long*)(ws + WS_CTL + 1024))[0] = __builtin_amdgcn_s_memrealtime();
        if (ph == PROF_HI && PROF_LO != 98) ((unsigned long long*)(ws + WS_CTL + 1024))[1] = __builtin_amdgcn_s_memrealtime();
    }
    const int lane = tid & 63, wave = __builtin_amdgcn_readfirstlane(tid >> 6);
    const int gw = bx * 8 + wave, NGW = G * 8, gtid = bx * 512 + tid, NGT = G * 512;
    bf16_t* ZH = (bf16_t*)(ws + WS_ZH); bf16_t* MRG = (bf16_t*)(ws + WS_MRG); bf16_t* KVb = (bf16_t*)(ws + WS_KV); bf16_t* MEMN = (bf16_t*)(ws + WS_MEMN);
    bf16_t* Y_A = ZH;
    bf16_t* H2A = (bf16_t*)(ws + WS_ZH + 64 * MiB);
    bf16_t* QB = (bf16_t*)(ws + WS_ZH + 128 * MiB);
    bf16_t* OB = (bf16_t*)(ws + WS_ZH + 192 * MiB);
    bf16_t* H2B = ZH;
    bf16_t* HID = (bf16_t*)(ws + WS_ZH + 64 * MiB);
    bf16_t* Win_t = (bf16_t*)(ws + WS_WIN); bf16_t* Wm_t = (bf16_t*)(ws + WS_WM); bf16_t* Wo_t = (bf16_t*)(ws + WS_WO); bf16_t* Wxq_t = (bf16_t*)(ws + WS_WXQ);
    bf16_t* Wxkv_t = (bf16_t*)(ws + WS_WXKV); bf16_t* Wxo_t = (bf16_t*)(ws + WS_WXO); bf16_t* W1_t = (bf16_t*)(ws + WS_W1); bf16_t* W2_t = (bf16_t*)(ws + WS_W2);
    const float* biasz = (const float*)(ws + WS_BIASZ);
    const float* x_in = a.in[0]; const float* mem = a.in[1]; const float* norms = a.in[2];
    float* xout = a.out;
    {
        if (ph == 0) {
            if (PROF_LO == 98) {
                if (bx == 0 && tid == 0) ((unsigned long long*)(ws + WS_CTL + 1024))[0] = __builtin_amdgcn_s_memrealtime();
                for (int i = 0; i < 16; ++i) xcd_barrier(xbar);
                if (bx == 0 && tid == 0) ((unsigned long long*)(ws + WS_CTL + 1024))[1] = __builtin_amdgcn_s_memrealtime();
            }
            LayerW L{a.in[3], a.in[4], a.in[10], a.in[11], a.in[12], a.in[13], a.in[14], a.in[15], a.in[16]};
            convert_weights(L, ws, lds, gw, NGW, wave, lane, gtid, NGT);
            norm_rows(x_in, nullptr, nullptr, nullptr, norms + 0 * D, ZH + HCOL, LDZ, MTOK, gw, NGW, lane);
            continue;
        }
        const int l = (ph - 1) / 12, k = (ph - 1) % 12 + 1;
        const float* gl = norms + (size_t)l * 7 * D;
        if (k == 1 || k == 4 || k == 6 || k == 8 || k == 10 || k == 11) {
            pg8::Gemm g; USched S; EpiStore E;
            S.G = G; S.c = bx; S.mode = 0; S.nM1 = 0; S.nN1 = 0; S.a1off = 0; S.b1off = 0; S.a0col = 0; S.nM0 = 128; S.nN0 = 4;
            E.O1 = nullptr; E.VT = nullptr; E.ldc1 = 0; E.bias = nullptr; E.act = 0; E.ldc0 = D;
            g.lda = D; g.K = D;
            if (k == 1) { g.A = ZH; g.Bt = Win_t; g.lda = LDZ; S.nN0 = 19; S.a0col = HCOL; E.O0 = ZH; E.ldc0 = LDZ; E.bias = biasz; }
            else if (k == 4) { g.A = MRG; g.Bt = Wo_t; E.O0 = Y_A; }
            else if (k == 6) { g.A = H2A; g.Bt = Wxq_t; S.mode = 1; S.nM1 = 16; S.nN1 = 8; S.a1off = (long)(MEMN - H2A); S.b1off = (long)(Wxkv_t - Wxq_t); E.O0 = QB; E.O1 = KVb; E.ldc1 = 1024; E.VT = KVb + (size_t)4096 * 1024; }
            else if (k == 8) { g.A = OB; g.Bt = Wxo_t; E.O0 = MRG; }
            else if (k == 10) { g.A = H2B; g.Bt = W1_t; S.nN0 = 16; E.O0 = HID; E.ldc0 = DFF; E.act = 2; }
            else { g.A = HID; g.Bt = W2_t; g.lda = DFF; g.K = DFF; E.O0 = MRG; }
            S.lda = g.lda; S.K = g.K;

#ifndef NO_GEMM
pg8::gemm_phase<EpiStore, USched, false>(lds, g, S, E, tid);
#endif

        } else if (k == 3) {
            pg8::Gemm g; g.A = ZH; g.Bt = Wm_t; g.lda = LDZ; g.K = D;
            USched S; S.G = G; S.c = bx; S.mode = 2; S.nM0 = 128; S.nN0 = 4; S.nM1 = 0; S.nN1 = 0; S.a1off = 0; S.b1off = 0; S.a0col = 0; S.lda = LDZ; S.K = D;
            EpiMerge E; E.Z = ZH; E.MRG = MRG; E.gbias = a.in[4] + (size_t)l * DIN + 4624;

#ifndef NO_MERGE
pg8::gemm_phase<EpiMerge, USched, true>(lds, g, S, E, tid);
#endif

        } else if (k == 2) {
            unsigned* ctr = (unsigned*)(ws + WS_CTL) + 64 * (l + 1);
            LAS int* qslot = (LAS int*)(lds + LDS_BYTES - 64);
            const float* convw = a.in[5] + (size_t)l * 4 * 1024; const float* mg = a.in[6] + (size_t)l * 512; const float* gnorm = a.in[7] + (size_t)l * 512;
            const float* gws = a.in[8] + (size_t)l * 4 * 128 * 128; const float* gbs = a.in[9] + (size_t)l * 4 * 128;
#define FETCH_ITEM() ({ __syncthreads(); if (tid == 0) *qslot = (int)atomicAdd(ctr, 1u); __syncthreads(); __builtin_amdgcn_readfirstlane(*qslot); })
            int it = FETCH_ITEM();
            while (it < 64) {
#ifndef NO_MLSTM
                mlstm_item(lds, ZH, convw, mg, it >> 2, it & 3, tid);
#endif
                if (PROF_HI == 97 && l == 0 && tid == 0) atomicMax((unsigned long long*)(ws + WS_CTL + 1024) + 1, (unsigned long long)__builtin_amdgcn_s_memrealtime());
                it = FETCH_ITEM();
            }
            while (it < 64 + 1024) {
                const int r = it - 64; const int bh = r >> 3, pp = 7 - (r & 7);
#ifndef NO_FOX
                fox_item(lds, ZH, bh >> 3, bh & 7, pp, tid);
#endif
                if (PROF_HI == 96 && l == 0 && tid == 0) atomicMax((unsigned long long*)(ws + WS_CTL + 1024) + 1, (unsigned long long)__builtin_amdgcn_s_memrealtime());
                it = FETCH_ITEM();
            }
            while (it < 64 + 1024 + 256) {
                const int r = it - 1088; const int sp = r & 15, bb = r >> 4;
#ifndef NO_GMLP
                gmlp_item(lds, ZH, gnorm, gws, gbs, bb, sp, tid);
#endif
                it = FETCH_ITEM();
            }
#undef FETCH_ITEM
        } else if (k == 7) {

#ifndef NO_XATTN
for (int it = bx; it < 1024; it += G) xattn_item(lds, QB, KVb, KVb + (size_t)4096 * 1024, OB, it >> 6, (it >> 4) & 3, it & 15, tid);
#endif

        } else if (k == 5) {
            norm_rows(l == 0 ? x_in : xout, xout, Y_A, gl + 1 * D, gl + 2 * D, H2A, D, MTOK, gw, NGW, lane);
            norm_rows(mem, nullptr, nullptr, nullptr, gl + 4 * D, MEMN, D, MEMR, gw, NGW, lane);
        } else if (k == 9) {
            norm_rows(xout, xout, MRG, gl + 3 * D, gl + 5 * D, H2B, D, MTOK, gw, NGW, lane);
        } else {
            if (l + 1 < DEPTH) {
                norm_rows(xout, xout, MRG, gl + 6 * D, norms + (size_t)(l + 1) * 7 * D, ZH + HCOL, LDZ, MTOK, gw, NGW, lane);
                const int n = l + 1;
                LayerW L{a.in[3] + (size_t)n * D * DIN, a.in[4] + (size_t)n * DIN, a.in[10] + (size_t)n * 3 * 512 * 1024, a.in[11] + (size_t)n * D * D, a.in[12] + (size_t)n * D * D,
                         a.in[13] + (size_t)n * D * 2 * D, a.in[14] + (size_t)n * D * D, a.in[15] + (size_t)n * D * DFF, a.in[16] + (size_t)n * DFF * D};
                convert_weights(L, ws, lds, gw, NGW, wave, lane, gtid, NGT);
            } else {
                norm_rows(xout, xout, MRG, gl + 6 * D, nullptr, nullptr, 0, MTOK, gw, NGW, lane);
                if (PROF_LO >= 0 && bx == 0) {
                    __syncthreads();
                    const unsigned long long* pt = (const unsigned long long*)(ws + WS_CTL + 1024);
                    long n = (PROF_LO == 99) ? 4000 : (long)((pt[1] - pt[0]) / 100ull);
                    if (n > 8192) n = 8192;
                    for (int i = tid; i < n; i += 512) xout[i] += 0.25f;
                }
            }
        }
    }
    }
}

extern "C" void kernel_launch(void* const* d_in, const int* in_sizes, int n_in, void* d_out, int out_size, void* d_ws, size_t ws_size, hipStream_t stream) {
    static int grid = 0;
    if (grid == 0) {
        if (n_in != 17 || ws_size < WS_END) { fprintf(stderr, "kernel_launch: unexpected n_in %d or ws_size %zu (< %zu)\n", n_in, ws_size, (size_t)WS_END); grid = -1; return; }
        int dev = 0, cus = 0, per_cu = 0;
        (void)hipGetDevice(&dev);
        (void)hipDeviceGetAttribute(&cus, hipDeviceAttributeMultiprocessorCount, dev);
        if (hipFuncSetAttribute((const void*)fwd_kernel, hipFuncAttributeMaxDynamicSharedMemorySize, LDS_BYTES) != hipSuccess) { fprintf(stderr, "kernel_launch: hipFuncSetAttribute failed\n"); }
        if (hipOccupancyMaxActiveBlocksPerMultiprocessor(&per_cu, (const void*)fwd_kernel, 512, LDS_BYTES) != hipSuccess || per_cu < 1) { fprintf(stderr, "kernel_launch: occupancy query says %d\n", per_cu); per_cu = 1; }
        (void)hipGetLastError();
        if (cus <= 0) cus = 256;
        if (cus < 256) fprintf(stderr, "kernel_launch: device reports %d CUs; this kernel is built for a 256-workgroup cooperative grid\n", cus);
        grid = 256;
    }
    if (grid < 0) return;
#if MK_MULTI
    (void)hipMemsetAsync((char*)d_ws + WS_CTL, 0, 32768, stream);
#endif
    Args a{};
    for (int i = 0; i < 17; ++i) a.in[i] = (const float*)d_in[i];
    a.out = (float*)d_out; a.ws = (unsigned char*)d_ws;
#if MK_MULTI
    for (int ph = 0; ph < NPHASE; ++ph) {
        a.ph_lo = ph; a.ph_hi = ph + 1;
        hipLaunchKernelGGL(fwd_kernel, dim3(grid), dim3(512), LDS_BYTES, stream, a);
    }
#else
    a.ph_lo = 0; a.ph_hi = NPHASE;
    void* args[] = {&a};
    hipError_t e = hipLaunchCooperativeKernel((const void*)fwd_kernel, dim3(grid), dim3(512), args, LDS_BYTES, stream);
    if (e != hipSuccess) fprintf(stderr, "cooperative launch failed: %s (grid %d)\n", hipGetErrorString(e), grid);
#endif
}
```
